# Optimizing an MI355X kernel written in HIP

```python
import math
import jax, jax.numpy as jnp
from jax import lax
import numpy as np

D_MODEL = 1024
BATCH = 8
SEQ = 4096
DEPTH = 4

N_MIXERS = 2
N_RET_LAYERS = (DEPTH + N_MIXERS - 1) // N_MIXERS
N_NA_LAYERS = DEPTH // N_MIXERS

MIX_WIDTH = D_MODEL
MEM_LEN = 256
MEM_HEADS = 4
MEM_WIDTH = D_MODEL // 4
MEM_HEAD_DIM = MEM_WIDTH // MEM_HEADS
TOK_WIDTH = MIX_WIDTH - MEM_WIDTH

RET_HEADS = 6
RET_HEAD_DIM = TOK_WIDTH // RET_HEADS
RET_CHUNK = 128
RET_ROPE_BASE = 10000.0
GN_EPS = 1e-5

NA_HEADS = 12
NA_HEAD_DIM = TOK_WIDTH // NA_HEADS
GRID_W = 64
NA_WIN_R = 8
NA_WIN_C = 16
NA_QB = 16
NA_KB = 32

FFN_HIDDEN = ((8 * D_MODEL + 3 * 256 - 1) // (3 * 256)) * 256
EPS = 1e-6

kernel_name = "hybrid_retention_natten_memory_encoder"


def rms_norm(x, g):
    xf = x.astype(jnp.float32)
    y = xf * lax.rsqrt(jnp.mean(xf * xf, axis=-1, keepdims=True) + EPS)
    return (y * g.astype(jnp.float32)).astype(x.dtype)


def to_heads(t, n_heads):
    b, s, w = t.shape
    return t.reshape(b, s, n_heads, w // n_heads).transpose(0, 2, 1, 3)


def from_heads(t):
    b, n, s, d = t.shape
    return t.transpose(0, 2, 1, 3).reshape(b, s, n * d)


def rotary(t, pos):
    d = t.shape[-1]
    half = d // 2
    inv = RET_ROPE_BASE ** (-jnp.arange(half, dtype=jnp.float32) / half)
    ang = pos[:, None] * inv[None, :]
    c, s = jnp.cos(ang), jnp.sin(ang)
    t1, t2 = t[..., :half], t[..., half:]
    return jnp.concatenate([t1 * c - t2 * s, t1 * s + t2 * c], axis=-1)


def retention_one_direction(q, k, v, log_gamma):
    b, h, t, dk = q.shape
    dv = v.shape[-1]
    c = RET_CHUNK
    n = t // c
    qc = q.reshape(b, h, n, c, dk)
    kc = k.reshape(b, h, n, c, dk)
    vc = v.reshape(b, h, n, c, dv)
    idx = jnp.arange(c, dtype=jnp.float32)
    rel = idx[:, None] - idx[None, :]
    lg = log_gamma[:, None, None]
    intra_decay = jnp.where(rel >= 0, jnp.exp(lg * jnp.maximum(rel, 0.0)), 0.0)
    scores = jnp.einsum('bhncd,bhnsd->bhncs', qc, kc) * intra_decay[None, :, None]
    out = jnp.einsum('bhncs,bhnse->bhnce', scores, vc)
    k_dec = jnp.exp(log_gamma[:, None] * (c - 1 - idx)[None, :])
    q_dec = jnp.exp(log_gamma[:, None] * (idx + 1)[None, :])
    chunk_dec = jnp.exp(log_gamma * c)[None, :, None, None]
    kv = jnp.einsum('bhncd,bhnce->nbhde', kc * k_dec[None, :, None, :, None], vc)

    def step(state, kv_n):
        return state * chunk_dec + kv_n, state

    _, prev = lax.scan(step, jnp.zeros((b, h, dk, dv), jnp.float32), kv)
    out = out + jnp.einsum('bhncd,nbhde->bhnce', qc * q_dec[None, :, None, :, None], prev)
    return out.reshape(b, h, t, dv)


def memory_attention(mq, mem_k, mem_v):
    b, s, _ = mq.shape
    qh = mq.reshape(b, s, MEM_HEADS, MEM_HEAD_DIM)
    sc = jnp.einsum('bthd,blhd->bhtl', qh, mem_k).astype(jnp.float32) * (MEM_HEAD_DIM ** -0.5)
    p = jax.nn.softmax(sc, axis=-1).astype(mem_v.dtype)
    o = jnp.einsum('bhtl,blhd->bthd', p, mem_v)
    return o.reshape(b, s, MEM_WIDTH)


def retention_layer(a, mem_k, mem_v, w_in, w_out, gn_g, gn_b, decay):
    b, s, _ = a.shape
    proj = a @ w_in
    q, k, v, g, mq = jnp.split(proj, [TOK_WIDTH, 2 * TOK_WIDTH, 3 * TOK_WIDTH, 4 * TOK_WIDTH], axis=-1)
    pos = jnp.arange(s, dtype=jnp.float32)
    qh = rotary(to_heads(q, RET_HEADS).astype(jnp.float32), pos)
    kh = rotary(to_heads(k, RET_HEADS).astype(jnp.float32), pos) * (RET_HEAD_DIM ** -0.5)
    vh = to_heads(v, RET_HEADS).astype(jnp.float32)
    log_gamma = -jnp.exp(decay.astype(jnp.float32))
    y_fwd = retention_one_direction(qh, kh, vh, log_gamma[0])
    y_bwd = jnp.flip(retention_one_direction(jnp.flip(qh, 2), jnp.flip(kh, 2), jnp.flip(vh, 2),
                                             log_gamma[1]), 2)
    y = y_fwd + y_bwd
    mu = jnp.mean(y, axis=-1, keepdims=True)
    var = jnp.mean(jnp.square(y - mu), axis=-1, keepdims=True)
    y = from_heads((y - mu) * lax.rsqrt(var + GN_EPS))
    y = y * gn_g.astype(jnp.float32) + gn_b.astype(jnp.float32)
    y = (jax.nn.silu(g.astype(jnp.float32)) * y).astype(a.dtype)
    m = memory_attention(mq, mem_k, mem_v)
    return jnp.concatenate([y, m], axis=-1) @ w_out


def neighbourhood_attention(q, k, v, rpb):
    b, h, t, d = q.shape
    rows = t // GRID_W
    wr = min(NA_WIN_R, rows)
    wc = NA_WIN_C
    n_cb = GRID_W // NA_QB
    qg = q.reshape(b, h, rows, n_cb, NA_QB, d) * (d ** -0.5)
    kg = k.reshape(b, h, rows, GRID_W, d)
    vg = v.reshape(b, h, rows, GRID_W, d)
    qcol = np.arange(GRID_W).reshape(n_cb, NA_QB)
    kstart = np.clip(np.arange(n_cb) * NA_QB - NA_WIN_C // 2, 0, GRID_W - NA_KB)
    kcol = kstart[:, None] + np.arange(NA_KB)[None, :]
    wstart = np.clip(qcol - wc // 2, 0, GRID_W - wc)
    col_valid = (kcol[:, None, :] >= wstart[:, :, None]) & (kcol[:, None, :] < wstart[:, :, None] + wc)
    dc_idx = np.clip(kcol[:, None, :] - qcol[:, :, None] + NA_WIN_C - 1, 0, 2 * NA_WIN_C - 2)
    mask = jnp.asarray(col_valid)[:, :, None, :]
    rpb_c = rpb[:, :, dc_idx].astype(jnp.float32)

    def one_row(r):
        rs = jnp.clip(r - wr // 2, 0, rows - wr)
        k_blk = lax.dynamic_slice_in_dim(kg, rs, wr, axis=2)[:, :, :, kcol]
        v_blk = lax.dynamic_slice_in_dim(vg, rs, wr, axis=2)[:, :, :, kcol]
        q_row = lax.dynamic_index_in_dim(qg, r, axis=2, keepdims=False)
        s = jnp.einsum('bhjqd,bhrjkd->bhjqrk', q_row, k_blk).astype(jnp.float32)
        dr_idx = rs + jnp.arange(wr) - r + NA_WIN_R - 1
        bias = jnp.take(rpb_c, dr_idx, axis=1).transpose(0, 2, 3, 1, 4)
        s = jnp.where(mask, s + bias, -1e30)
        p = jax.nn.softmax(s, axis=(-2, -1)).astype(v.dtype)
        return jnp.einsum('bhjqrk,bhrjkd->bhjqd', p, v_blk)

    out = lax.map(one_row, jnp.arange(rows))
    return out.transpose(1, 2, 0, 3, 4, 5).reshape(b, h, t, d)


def na_layer(a, mem_k, mem_v, w_in, w_out, rpb):
    proj = a @ w_in
    q, k, v, mq = jnp.split(proj, [TOK_WIDTH, 2 * TOK_WIDTH, 3 * TOK_WIDTH], axis=-1)
    o = neighbourhood_attention(to_heads(q, NA_HEADS), to_heads(k, NA_HEADS), to_heads(v, NA_HEADS), rpb)
    m = memory_attention(mq, mem_k, mem_v)
    return jnp.concatenate([from_heads(o), m], axis=-1) @ w_out


def setup_inputs(seed: int = 0) -> dict:
    key = jax.random.key(seed)
    ks = jax.random.split(key, 16)
    f32 = jnp.float32
    x = jax.random.normal(ks[0], (BATCH, SEQ, D_MODEL), f32)
    mem = jax.random.normal(ks[1], (BATCH, MEM_LEN, D_MODEL), f32)
    norm_g = 1.0 + 0.02 * jax.random.normal(ks[2], (DEPTH, 4, D_MODEL), f32)
    mem_norm_g = 1.0 + 0.02 * jax.random.normal(ks[3], (D_MODEL,), f32)
    mem_w_kv = jax.random.normal(ks[4], (D_MODEL, 2 * MEM_WIDTH), f32) * D_MODEL ** -0.5
    ret_w_in = jax.random.normal(ks[5], (N_RET_LAYERS, D_MODEL, 4 * TOK_WIDTH + MEM_WIDTH), f32) * D_MODEL ** -0.5
    ret_w_out = jax.random.normal(ks[6], (N_RET_LAYERS, MIX_WIDTH, D_MODEL), f32) * MIX_WIDTH ** -0.5
    ret_gn_g = 1.0 + 0.02 * jax.random.normal(ks[7], (N_RET_LAYERS, TOK_WIDTH), f32)
    ret_gn_b = 0.02 * jax.random.normal(ks[8], (N_RET_LAYERS, TOK_WIDTH), f32)
    base = jnp.log(-jnp.log(1.0 - 2.0 ** (-5.0 - jnp.arange(RET_HEADS, dtype=f32))))
    ret_decay = base[None, None, :] + 0.05 * jax.random.normal(ks[9], (N_RET_LAYERS, 2, RET_HEADS), f32)
    na_w_in = jax.random.normal(ks[10], (N_NA_LAYERS, D_MODEL, 3 * TOK_WIDTH + MEM_WIDTH), f32) * D_MODEL ** -0.5
    na_w_out = jax.random.normal(ks[11], (N_NA_LAYERS, MIX_WIDTH, D_MODEL), f32) * MIX_WIDTH ** -0.5
    na_rpb = 0.1 * jax.random.normal(ks[12], (N_NA_LAYERS, NA_HEADS, 2 * NA_WIN_R - 1, 2 * NA_WIN_C - 1), f32)
    ffn_w_in = jax.random.normal(ks[13], (DEPTH, D_MODEL, 2 * FFN_HIDDEN), f32) * D_MODEL ** -0.5
    ffn_w_out = jax.random.normal(ks[14], (DEPTH, FFN_HIDDEN, D_MODEL), f32) * FFN_HIDDEN ** -0.5
    return {"x": x, "mem": mem, "norm_g": norm_g, "mem_norm_g": mem_norm_g, "mem_w_kv": mem_w_kv,
            "ret_w_in": ret_w_in, "ret_w_out": ret_w_out, "ret_gn_g": ret_gn_g, "ret_gn_b": ret_gn_b,
            "ret_decay": ret_decay, "na_w_in": na_w_in, "na_w_out": na_w_out, "na_rpb": na_rpb,
            "ffn_w_in": ffn_w_in, "ffn_w_out": ffn_w_out}


def reference(x, mem, norm_g, mem_norm_g, mem_w_kv, ret_w_in, ret_w_out, ret_gn_g, ret_gn_b,
              ret_decay, na_w_in, na_w_out, na_rpb, ffn_w_in, ffn_w_out):
    b, l, _ = mem.shape
    mkv = rms_norm(mem, mem_norm_g) @ mem_w_kv
    mem_k, mem_v = jnp.split(mkv, 2, axis=-1)
    mem_k = mem_k.reshape(b, l, MEM_HEADS, MEM_HEAD_DIM)
    mem_v = mem_v.reshape(b, l, MEM_HEADS, MEM_HEAD_DIM)
    h = x
    for i in range(DEPTH):
        j = i // N_MIXERS
        a = rms_norm(h, norm_g[i, 0])
        if i % N_MIXERS == 0:
            y = retention_layer(a, mem_k, mem_v, ret_w_in[j], ret_w_out[j], ret_gn_g[j], ret_gn_b[j], ret_decay[j])
        else:
            y = na_layer(a, mem_k, mem_v, na_w_in[j], na_w_out[j], na_rpb[j])
        h = h + rms_norm(y, norm_g[i, 1])
        a = rms_norm(h, norm_g[i, 2])
        gate, up = jnp.split(a @ ffn_w_in[i], 2, axis=-1)
        f = (jax.nn.silu(gate) * up) @ ffn_w_out[i]
        h = h + rms_norm(f, norm_g[i, 3])
    return h
```

```cpp
#include <hip/hip_runtime.h>
#include <hip/hip_cooperative_groups.h>
#include <cstdio>
namespace cg = cooperative_groups;

#ifndef ONE_LAUNCH
#define ONE_LAUNCH 1
#endif

#define LAS __attribute__((address_space(3)))
typedef unsigned short bf16_t;
typedef short bf16x8 __attribute__((ext_vector_type(8)));
typedef float f32x4 __attribute__((ext_vector_type(4)));
typedef unsigned u32x4 __attribute__((ext_vector_type(4)));
typedef unsigned u32x2 __attribute__((ext_vector_type(2)));

constexpr int MTOK = 32768, DM = 1024, SEQ = 4096, NB = 8;
constexpr int LDR = 3328;
constexpr int LDN = 1792;
constexpr int FF = 2816;
constexpr int LDS_BYTES = 163840;

constexpr size_t WS_ABUF = 0;
constexpr size_t WS_R1   = WS_ABUF + (size_t)MTOK * 1024 * 2;
constexpr size_t WS_MIX  = WS_R1 + (size_t)MTOK * LDR * 2;
constexpr size_t WS_W    = WS_MIX + (size_t)MTOK * 1024 * 2;
constexpr size_t W_IN_OFF = 0, W_OUT_OFF = (size_t)3328 * 1024, W_F1_OFF = W_OUT_OFF + (size_t)1024 * 1024, W_F2_OFF = W_F1_OFF + (size_t)5632 * 1024, W_ELEMS = W_F2_OFF + (size_t)1024 * FF;
constexpr size_t WS_ST   = WS_W + W_ELEMS * 2;
constexpr size_t WS_MEMW = WS_ST + (size_t)48 * 2 * 32 * 16384 * 2;
constexpr size_t WS_MEMN = WS_MEMW + (size_t)512 * 1024 * 2;
constexpr size_t WS_MKV  = WS_MEMN + (size_t)2048 * 1024 * 2;
constexpr size_t WS_MVT  = WS_MKV + (size_t)2048 * 512 * 2;
constexpr size_t WS_COS  = WS_MVT + (size_t)2048 * 256 * 2;
constexpr size_t WS_SIN  = WS_COS + (size_t)4096 * 64 * 4;
constexpr size_t WS_BAR  = WS_SIN + (size_t)4096 * 64 * 4;
constexpr size_t WS_END  = WS_BAR + 16384;

typedef __bf16 bf16x2_t __attribute__((ext_vector_type(2)));
__device__ __forceinline__ unsigned cvt_pk_bf16(float lo, float hi) { bf16x2_t v; v[0] = (__bf16)lo; v[1] = (__bf16)hi; return __builtin_bit_cast(unsigned, v); }
__device__ __forceinline__ unsigned cvt_pk_bf16_nv(float lo, float hi) { return cvt_pk_bf16(lo, hi); }
__device__ __forceinline__ float bf_lo(unsigned u) { return __uint_as_float(u << 16); }
__device__ __forceinline__ float bf_hi(unsigned u) { return __uint_as_float(u & 0xffff0000u); }
__device__ __forceinline__ bf16_t f2bf(float f) { return (bf16_t)(cvt_pk_bf16(f, 0.f) & 0xffffu); }
__device__ __forceinline__ float silu_f(float x) { return x * __builtin_amdgcn_rcpf(1.0f + __expf(-x)); }
__device__ __forceinline__ int clampi(int v, int lo, int hi) { return v < lo ? lo : (v > hi ? hi : v); }

namespace pg8 {
constexpr int BM = 256, BK = 64, HALF = 128, HTB = HALF * BK * 2, STAGE_BYTES = 8 * HTB, NXCD = 8, WGM = 8;
__device__ __forceinline__ int lds_byte(int r, int c) { const int st = (r >> 4) * 2 + (c >> 5), rr = r & 15, cc = c & 31, ob = rr * 64 + cc * 2; return st * 1024 + (ob ^ (((ob >> 9) & 1) << 5)); }
__device__ __forceinline__ void stage_rc(int b, int& R, int& C) { const int st = b / 1024, sb = b % 1024, swz = sb ^ (((sb >> 9) & 1) << 5); R = (st >> 1) * 16 + swz / 64; C = (st & 1) * 32 + (swz % 64) / 2; }
__device__ __forceinline__ int perm32(int rho) { const int n = rho >> 4, i = rho & 15; return 8 * (i >> 2) + 4 * n + (i & 3); }
struct Unit { int pm, pn; };
struct Gemm { const bf16_t* A; const bf16_t* Bt; int M, N, K; };
struct StaticOrder {
    int nM, nN, nwg, G, c;
    __device__ void init(int M, int N, int G_, int c_) { nM = M / BM; nN = N / BM; nwg = nM * nN; G = G_; c = c_; }
    __device__ bool next(int i, Unit& u) const {
        const long L = (long)i * G + c; if (L >= nwg) return false;
        int wgid = (int)L; { const int q = nwg / NXCD, r = nwg % NXCD, xcd = wgid % NXCD, off = wgid / NXCD; wgid = (xcd < r ? xcd * (q + 1) : r * (q + 1) + (xcd - r) * q) + off; }
        const int nig = WGM * nN, gid = wgid / nig, fm = gid * WGM, gsz = (nM - fm) < WGM ? (nM - fm) : WGM;
        u.pm = fm + ((wgid % nig) % gsz); u.pn = (wgid % nig) / gsz; return true;
    }
};
struct EpiBf16 {
    static constexpr bool PERM = true;
    bf16_t* O; int ldc;
    __device__ __forceinline__ void operator()(const f32x4 (&acc)[2][2][4][2], const Unit& u, int wr, int wc, int fr, int fq) const {
        const int row0 = u.pm * BM + wr * 64 + fr, col0 = u.pn * BM + wc * 32 + 8 * fq;
#pragma unroll
        for (int ai = 0; ai < 2; ++ai)
#pragma unroll
            for (int m = 0; m < 4; ++m) { bf16_t* rowp = O + (size_t)(row0 + ai * HALF + m * 16) * ldc + col0;
#pragma unroll
                for (int bj = 0; bj < 2; ++bj) { const f32x4 v0 = acc[ai][bj][m][0], v1 = acc[ai][bj][m][1];
                    u32x4 w; w.x = cvt_pk_bf16(v0[0], v0[1]); w.y = cvt_pk_bf16(v0[2], v0[3]); w.z = cvt_pk_bf16(v1[0], v1[1]); w.w = cvt_pk_bf16(v1[2], v1[3]);
                    *(u32x4*)(rowp + bj * HALF) = w; } }
    }
};
struct EpiSwiglu {
    static constexpr bool PERM = true;
    bf16_t* O; int ldc;
    __device__ __forceinline__ void operator()(const f32x4 (&acc)[2][2][4][2], const Unit& u, int wr, int wc, int fr, int fq) const {
        const int row0 = u.pm * BM + wr * 64 + fr, col0 = u.pn * HALF + wc * 32 + 8 * fq;
#pragma unroll
        for (int ai = 0; ai < 2; ++ai)
#pragma unroll
            for (int m = 0; m < 4; ++m) { bf16_t* rowp = O + (size_t)(row0 + ai * HALF + m * 16) * ldc + col0;
                float h[8], ex[8];
#pragma unroll
                for (int q = 0; q < 8; ++q) ex[q] = __builtin_amdgcn_exp2f(acc[ai][0][m][q >> 2][q & 3] * -1.4426950408889634f);
#pragma unroll
                for (int q = 0; q < 8; ++q) ex[q] = __builtin_amdgcn_rcpf(1.0f + ex[q]);
#pragma unroll
                for (int q = 0; q < 8; ++q) h[q] = (acc[ai][0][m][q >> 2][q & 3] * acc[ai][1][m][q >> 2][q & 3]) * ex[q];
                u32x4 w; w.x = cvt_pk_bf16_nv(h[0], h[1]); w.y = cvt_pk_bf16_nv(h[2], h[3]); w.z = cvt_pk_bf16_nv(h[4], h[5]); w.w = cvt_pk_bf16_nv(h[6], h[7]);
                *(u32x4*)rowp = w; }
    }
};

template <class Epi, class Sched>
__device__ __forceinline__ void gemm_phase(LAS unsigned char* lds, const Gemm g, const Sched& S, const Epi& E, int tid) {
    const int wid = __builtin_amdgcn_readfirstlane(tid >> 6), lane = tid & 63, wr = wid >> 2, wc = wid & 3, fr = lane & 15, fq = lane >> 4;
    const int K = g.K, nt = K / BK;
    unsigned voffA[2], voffB[2];
#pragma unroll
    for (int i = 0; i < 2; ++i) { int R, C; stage_rc(tid * 16 + i * 8192, R, C); const int Rb = Epi::PERM ? ((R & ~31) + perm32(R & 31)) : R;
        voffA[i] = (unsigned)(R * K + C) * 2u; voffB[i] = (unsigned)(Rb * K + C) * 2u; }
    const size_t kstep = (size_t)(BK * 2);
    const size_t hstep = (size_t)HALF * K * 2;
    const size_t tstep = 2 * hstep;
    const unsigned ldsw = (unsigned)wid * 1024u;
    const int aoff = lds_byte(wr * 64 + fr, fq * 8), boff = lds_byte(wc * 32 + fr, fq * 8);
#define PG8_SA(b, h) (((b) * 2 + (h)) * HTB)
#define PG8_SB(b, h) ((4 + (b) * 2 + (h)) * HTB)
#define PG8_STAGE(bufoff, gbase, voff) do { _Pragma("unroll") for (int _i = 0; _i < 2; ++_i) \
        __builtin_amdgcn_global_load_lds((const unsigned*)((const char*)(gbase) + (voff)[_i]), (LAS unsigned*)(lds + (bufoff) + ldsw + _i * 8192), 16, 0, 0); } while (0)
#define PG8_LDA(dst, b, h) do { _Pragma("unroll") for (int m = 0; m < 4; ++m) _Pragma("unroll") for (int k = 0; k < 2; ++k) dst[m][k] = *(const LAS bf16x8*)(lds + PG8_SA(b, h) + aoff + m * 2048 + k * 1024); } while (0)
#define PG8_LDB(dst, b, h) do { _Pragma("unroll") for (int n = 0; n < 2; ++n) _Pragma("unroll") for (int k = 0; k < 2; ++k) dst[n][k] = *(const LAS bf16x8*)(lds + PG8_SB(b, h) + boff + n * 2048 + k * 1024); } while (0)
#define PG8_MMA(ai, bj, At, Bt) do { __builtin_amdgcn_s_setprio(3); _Pragma("unroll") for (int m = 0; m < 4; ++m) _Pragma("unroll") for (int n = 0; n < 2; ++n) _Pragma("unroll") for (int k = 0; k < 2; ++k) \
        acc[ai][bj][m][n] = __builtin_amdgcn_mfma_f32_16x16x32_bf16(Bt[n][k], At[m][k], acc[ai][bj][m][n], 0, 0, 0); __builtin_amdgcn_s_setprio(0); } while (0)
#define PG8_WAIT_V(n) asm volatile("s_waitcnt vmcnt(" #n ")" ::: "memory")
#define PG8_WAIT_L(n) asm volatile("s_waitcnt lgkmcnt(" #n ")" ::: "memory")
#define PG8_BAR __builtin_amdgcn_s_barrier()
#define PG8_SCHED __builtin_amdgcn_sched_barrier(0)
    Unit cur, nxt; int ui = 0;
    if (!S.next(0, cur)) return;
    f32x4 acc[2][2][4][2];
#pragma unroll
    for (int a = 0; a < 2; ++a)
#pragma unroll
        for (int b = 0; b < 2; ++b)
#pragma unroll
            for (int m = 0; m < 4; ++m)
#pragma unroll
                for (int n = 0; n < 2; ++n) acc[a][b][m][n] = (f32x4){0.f, 0.f, 0.f, 0.f};
    bf16x8 At[4][2], B0[2][2], B1[2][2];
    const char* cA = (const char*)g.A + (size_t)cur.pm * tstep; const char* cB = (const char*)g.Bt + (size_t)cur.pn * tstep;
    PG8_STAGE(PG8_SB(0, 0), cB, voffB); PG8_STAGE(PG8_SA(0, 0), cA, voffA); PG8_STAGE(PG8_SB(0, 1), cB + hstep, voffB); PG8_STAGE(PG8_SA(0, 1), cA + hstep, voffA);
    if (wr == 1) PG8_BAR;
    PG8_WAIT_V(4); PG8_BAR;
    PG8_STAGE(PG8_SB(1, 0), cB + kstep, voffB); PG8_STAGE(PG8_SA(1, 0), cA + kstep, voffA); PG8_STAGE(PG8_SB(1, 1), cB + hstep + kstep, voffB);
    PG8_WAIT_V(6); PG8_BAR;
    for (;;) {
        const bool has_next = S.next(ui + 1, nxt);
        const char* nA = has_next ? (const char*)g.A + (size_t)nxt.pm * tstep : cA; const char* nB = has_next ? (const char*)g.Bt + (size_t)nxt.pn * tstep : cB;
        for (int t = 0; t < nt; t += 2) {
            const bool last = (t == nt - 2);
            const char* a1 = cA + (size_t)(t + 1) * kstep;
            const char* a2 = last ? nA : cA + (size_t)(t + 2) * kstep; const char* b2 = last ? nB : cB + (size_t)(t + 2) * kstep;
            const char* a3 = a2 + kstep; const char* b3 = b2 + kstep;
            PG8_LDB(B0, 0, 0); PG8_SCHED; PG8_LDA(At, 0, 0); PG8_STAGE(PG8_SA(1, 1), a1 + hstep, voffA);
            PG8_WAIT_L(8); PG8_BAR; PG8_WAIT_L(0); PG8_MMA(0, 0, At, B0); PG8_BAR; PG8_SCHED;
            PG8_LDB(B1, 0, 1); PG8_STAGE(PG8_SB(0, 0), b2, voffB);
            PG8_BAR; PG8_WAIT_L(0); PG8_MMA(0, 1, At, B1); PG8_BAR;
            PG8_LDA(At, 0, 1); PG8_STAGE(PG8_SA(0, 0), a2, voffA);
            PG8_BAR; PG8_WAIT_L(0); PG8_MMA(1, 0, At, B0); PG8_BAR; PG8_SCHED;
            PG8_STAGE(PG8_SB(0, 1), b2 + hstep, voffB);
            PG8_WAIT_V(6); PG8_BAR; PG8_MMA(1, 1, At, B1); PG8_BAR;
            PG8_LDB(B0, 1, 0); PG8_SCHED; PG8_LDA(At, 1, 0); PG8_STAGE(PG8_SA(0, 1), a2 + hstep, voffA);
            PG8_WAIT_L(8); PG8_BAR; PG8_WAIT_L(0); PG8_MMA(0, 0, At, B0); PG8_BAR; PG8_SCHED;
            PG8_LDB(B1, 1, 1); PG8_STAGE(PG8_SB(1, 0), b3, voffB);
            PG8_BAR; PG8_WAIT_L(0); PG8_MMA(0, 1, At, B1); PG8_BAR;
            PG8_LDA(At, 1, 1); PG8_STAGE(PG8_SA(1, 0), a3, voffA);
            PG8_BAR; PG8_WAIT_L(0); PG8_MMA(1, 0, At, B0); PG8_BAR; PG8_SCHED;
            PG8_STAGE(PG8_SB(1, 1), b3 + hstep, voffB);
            PG8_WAIT_V(6); PG8_BAR; PG8_MMA(1, 1, At, B1); PG8_BAR;
        }
        E(acc, cur, wr, wc, fr, fq);
        if (!has_next) break;
#pragma unroll
        for (int a = 0; a < 2; ++a)
#pragma unroll
            for (int b = 0; b < 2; ++b)
#pragma unroll
                for (int m = 0; m < 4; ++m)
#pragma unroll
                    for (int n = 0; n < 2; ++n) acc[a][b][m][n] = (f32x4){0.f, 0.f, 0.f, 0.f};
        cur = nxt; cA = nA; cB = nB; ++ui;
    }
    PG8_WAIT_V(0);
    if (wr == 0) PG8_BAR;
    PG8_BAR;
#undef PG8_SA
#undef PG8_SB
#undef PG8_STAGE
#undef PG8_LDA
#undef PG8_LDB
#undef PG8_MMA
#undef PG8_WAIT_V
#undef PG8_WAIT_L
#undef PG8_BAR
#undef PG8_SCHED
}
}

struct Params {
    const float* x; const float* mem; const float* norm_g; const float* mem_norm_g; const float* mem_w_kv;
    const float* ret_w_in; const float* ret_w_out; const float* ret_gn_g; const float* ret_gn_b; const float* ret_decay;
    const float* na_w_in; const float* na_w_out; const float* na_rpb; const float* ffn_w_in; const float* ffn_w_out;
    float* out; unsigned char* ws; int ph_lo, ph_hi;
};

typedef const __attribute__((address_space(4))) char* kargp_t;
#define KARG(T, field) (*(T const __attribute__((address_space(4)))*)(ka + __builtin_offsetof(Params, field)))
__device__ __forceinline__ int wsrc(int mode, int n0) {
    if (mode == 1) { const int pn = n0 >> 8, bj = (n0 >> 7) & 1, c0 = n0 & 127; return bj * FF + 128 * pn + c0; }
    if (mode == 2) { return n0 < 1536 ? n0 : (n0 < 1792 ? n0 + 768 : n0 - 256); }
    return n0;
}
__device__ __forceinline__ void wconv(const float* W, int K, int N, bf16_t* Bt, int mode, unsigned char* lds, int tid, int bx) {
    float* tile = (float*)lds;
    const int nkt = K / 128, ntiles = nkt * (N / 64);
    for (int t = bx; t < ntiles; t += gridDim.x) {
        const int kt = t % nkt, nt = t / nkt, n0 = nt * 64, k0 = kt * 128, s0 = wsrc(mode, n0);
        const int r = tid >> 4, c4 = (tid & 15) * 4;
        float4 v[4];
#pragma unroll
        for (int hh = 0; hh < 4; ++hh) v[hh] = *(const float4*)(W + (size_t)(k0 + r + hh * 32) * N + s0 + c4);
        __syncthreads();
#pragma unroll
        for (int hh = 0; hh < 4; ++hh) { const int rr = r + hh * 32; tile[rr * 65 + c4] = v[hh].x; tile[rr * 65 + c4 + 1] = v[hh].y; tile[rr * 65 + c4 + 2] = v[hh].z; tile[rr * 65 + c4 + 3] = v[hh].w; }
        __syncthreads();
        { const int j = tid >> 3, i0 = (tid & 7) * 16; float x[16];
#pragma unroll
          for (int ii = 0; ii < 16; ++ii) x[ii] = tile[(i0 + ii) * 65 + j];
          u32x4 w0, w1; w0.x = cvt_pk_bf16(x[0], x[1]); w0.y = cvt_pk_bf16(x[2], x[3]); w0.z = cvt_pk_bf16(x[4], x[5]); w0.w = cvt_pk_bf16(x[6], x[7]);
          w1.x = cvt_pk_bf16(x[8], x[9]); w1.y = cvt_pk_bf16(x[10], x[11]); w1.z = cvt_pk_bf16(x[12], x[13]); w1.w = cvt_pk_bf16(x[14], x[15]);
          bf16_t* dst = Bt + (size_t)(n0 + j) * K + k0 + i0; *(u32x4*)dst = w0; *(u32x4*)(dst + 8) = w1; }
    }
    __syncthreads();
}
__device__ __forceinline__ void conv_layer_weights(kargp_t ka, int i, unsigned char* lds, int tid, int bx) {
    bf16_t* Wb = (bf16_t*)(KARG(unsigned char*, ws) + WS_W); const int j = i >> 1;
    if (!(i & 1)) { wconv(KARG(const float*, ret_w_in) + (size_t)j * 1024 * 3328, 1024, 3328, Wb + W_IN_OFF, 0, lds, tid, bx); wconv(KARG(const float*, ret_w_out) + (size_t)j * 1024 * 1024, 1024, 1024, Wb + W_OUT_OFF, 0, lds, tid, bx); }
    else          { wconv(KARG(const float*, na_w_in) + (size_t)j * 1024 * 2560, 1024, 2560, Wb + W_IN_OFF, 2, lds, tid, bx);  wconv(KARG(const float*, na_w_out) + (size_t)j * 1024 * 1024, 1024, 1024, Wb + W_OUT_OFF, 0, lds, tid, bx); }
    wconv(KARG(const float*, ffn_w_in) + (size_t)i * 1024 * 5632, 1024, 5632, Wb + W_F1_OFF, 1, lds, tid, bx);
    wconv(KARG(const float*, ffn_w_out) + (size_t)i * FF * 1024, FF, 1024, Wb + W_F2_OFF, 0, lds, tid, bx);
}

__device__ __forceinline__ float wave_sum(float v) {
#pragma unroll
    for (int o = 32; o >= 1; o >>= 1) v += __shfl_xor(v, o);
    return v;
}
__device__ __forceinline__ void rownorm_first(const float* x, const float* g, bf16_t* a, int nrows, int tid, int bx) {
    const int lane = tid & 63, wave = tid >> 6;
    for (int row = bx * 8 + wave; row < nrows; row += gridDim.x * 8) {
        float4 v[4]; float ss = 0.f;
#pragma unroll
        for (int i = 0; i < 4; ++i) { v[i] = *(const float4*)(x + (size_t)row * 1024 + i * 256 + lane * 4); ss += v[i].x * v[i].x + v[i].y * v[i].y + v[i].z * v[i].z + v[i].w * v[i].w; }
        ss = wave_sum(ss); const float rs = 1.0f / sqrtf(ss * (1.0f / 1024.0f) + 1e-6f);
#pragma unroll
        for (int i = 0; i < 4; ++i) { const float4 gg = *(const float4*)(g + i * 256 + lane * 4);
            u32x2 w; w.x = cvt_pk_bf16(v[i].x * rs * gg.x, v[i].y * rs * gg.y); w.y = cvt_pk_bf16(v[i].z * rs * gg.z, v[i].w * rs * gg.w);
            *(u32x2*)(a + (size_t)row * 1024 + i * 256 + lane * 4) = w; }
    }
}
__device__ __forceinline__ void rowpass(const bf16_t* y, const float* hin, float* hout, const float* g1, const float* g2, bf16_t* a, int tid, int bx) {
    const int lane = tid & 63, wave = tid >> 6;
    for (int row0 = (bx * 8 + wave) * 2; row0 < MTOK; row0 += gridDim.x * 16) {
        u32x2 yw[2][4]; float4 h[2][4];
#pragma unroll
        for (int u = 0; u < 2; ++u)
#pragma unroll
            for (int i = 0; i < 4; ++i) { yw[u][i] = *(const u32x2*)(y + (size_t)(row0 + u) * 1024 + i * 256 + lane * 4); { const f32x4 t4 = __builtin_nontemporal_load((const f32x4*)(hin + (size_t)(row0 + u) * 1024 + i * 256 + lane * 4)); h[u][i] = make_float4(t4[0], t4[1], t4[2], t4[3]); } }
        float4 ga[4];
#pragma unroll
        for (int i = 0; i < 4; ++i) ga[i] = *(const float4*)(g1 + i * 256 + lane * 4);
        float yv[2][4][4]; float ss[2] = {0.f, 0.f};
#pragma unroll
        for (int u = 0; u < 2; ++u)
#pragma unroll
            for (int i = 0; i < 4; ++i) { yv[u][i][0] = bf_lo(yw[u][i].x); yv[u][i][1] = bf_hi(yw[u][i].x); yv[u][i][2] = bf_lo(yw[u][i].y); yv[u][i][3] = bf_hi(yw[u][i].y);
                ss[u] += yv[u][i][0] * yv[u][i][0] + yv[u][i][1] * yv[u][i][1] + yv[u][i][2] * yv[u][i][2] + yv[u][i][3] * yv[u][i][3]; }
#pragma unroll
        for (int o = 32; o >= 1; o >>= 1) { ss[0] += __shfl_xor(ss[0], o); ss[1] += __shfl_xor(ss[1], o); }
        float ss2[2] = {0.f, 0.f};
#pragma unroll
        for (int u = 0; u < 2; ++u) { const float rs = 1.0f / sqrtf(ss[u] * (1.0f / 1024.0f) + 1e-6f);
#pragma unroll
            for (int i = 0; i < 4; ++i) {
                h[u][i].x += yv[u][i][0] * rs * ga[i].x; h[u][i].y += yv[u][i][1] * rs * ga[i].y; h[u][i].z += yv[u][i][2] * rs * ga[i].z; h[u][i].w += yv[u][i][3] * rs * ga[i].w;
                __builtin_nontemporal_store((f32x4){h[u][i].x, h[u][i].y, h[u][i].z, h[u][i].w}, (f32x4*)(hout + (size_t)(row0 + u) * 1024 + i * 256 + lane * 4));
                ss2[u] += h[u][i].x * h[u][i].x + h[u][i].y * h[u][i].y + h[u][i].z * h[u][i].z + h[u][i].w * h[u][i].w; } }
        if (g2) {
#pragma unroll
            for (int o = 32; o >= 1; o >>= 1) { ss2[0] += __shfl_xor(ss2[0], o); ss2[1] += __shfl_xor(ss2[1], o); }
#pragma unroll
            for (int i = 0; i < 4; ++i) ga[i] = *(const float4*)(g2 + i * 256 + lane * 4);
#pragma unroll
            for (int u = 0; u < 2; ++u) { const float rs2 = 1.0f / sqrtf(ss2[u] * (1.0f / 1024.0f) + 1e-6f);
#pragma unroll
                for (int i = 0; i < 4; ++i) { u32x2 w; w.x = cvt_pk_bf16(h[u][i].x * rs2 * ga[i].x, h[u][i].y * rs2 * ga[i].y); w.y = cvt_pk_bf16(h[u][i].z * rs2 * ga[i].z, h[u][i].w * rs2 * ga[i].w);
                    *(u32x2*)(a + (size_t)(row0 + u) * 1024 + i * 256 + lane * 4) = w; } }
        }
    }
}
__device__ __forceinline__ void rope_table(float* cosT, float* sinT, int tid, int bx) {
    for (int idx = bx * 512 + tid; idx < SEQ * 64; idx += gridDim.x * 512) {
        const int t = idx >> 6, i = idx & 63;
        const float inv = exp2f(-(float)i * (13.287712379549449f / 64.0f));
        const float ang = (float)t * inv;
        double rv = (double)ang * 0.15915494309189535; rv -= rint(rv);
        cosT[idx] = __builtin_amdgcn_cosf((float)rv); sinT[idx] = __builtin_amdgcn_sinf((float)rv);
    }
}
template <bool UPFRONT, class KP, class VP, class MOD>
__device__ __forceinline__ void attn16(const bf16x8 (&qf)[2], KP kptr, VP vptr, MOD mod, bf16_t* outp  , int fr, int fq) {
    bf16x8 kf[16][2];
#pragma unroll
    for (int t = 0; t < 16; ++t) if (UPFRONT) { const int key = 32 * (t >> 1) + 8 * (fr >> 2) + 4 * (t & 1) + (fr & 3); kf[t][0] = kptr(key, 0); kf[t][1] = kptr(key, 1); }
    f32x4 st[16];
    float mx = -3.0e38f;
#pragma unroll
    for (int t = 0; t < 16; ++t) {
        f32x4 acc = (f32x4){0.f, 0.f, 0.f, 0.f};
        if (!UPFRONT) { const int key = 32 * (t >> 1) + 8 * (fr >> 2) + 4 * (t & 1) + (fr & 3); kf[t][0] = kptr(key, 0); kf[t][1] = kptr(key, 1); }
        acc = __builtin_amdgcn_mfma_f32_16x16x32_bf16(kf[t][0], qf[0], acc, 0, 0, 0);
        acc = __builtin_amdgcn_mfma_f32_16x16x32_bf16(kf[t][1], qf[1], acc, 0, 0, 0);
#pragma unroll
        for (int r = 0; r < 4; ++r) { const float v = mod(acc[r], t >> 1, t & 1, r); acc[r] = v; mx = fmaxf(mx, v); }
        st[t] = acc;
    }
    __builtin_amdgcn_sched_barrier(0);
    bf16x8 vf[8][4];
#pragma unroll
    for (int s = 0; s < 8; ++s)
#pragma unroll
        for (int dt = 0; dt < 4; ++dt) if (UPFRONT) vf[s][dt] = vptr(16 * dt + fr, s);
    mx = fmaxf(mx, __shfl_xor(mx, 16)); mx = fmaxf(mx, __shfl_xor(mx, 32));
    float sum = 0.f;
#pragma unroll
    for (int t = 0; t < 16; ++t)
#pragma unroll
        for (int r = 0; r < 4; ++r) { const float e = __expf(st[t][r] - mx); st[t][r] = e; sum += e; }
    sum += __shfl_xor(sum, 16); sum += __shfl_xor(sum, 32);
    f32x4 o[4];
#pragma unroll
    for (int dt = 0; dt < 4; ++dt) o[dt] = (f32x4){0.f, 0.f, 0.f, 0.f};
#pragma unroll
    for (int s = 0; s < 8; ++s) {
        u32x4 pw; pw.x = cvt_pk_bf16(st[2 * s][0], st[2 * s][1]); pw.y = cvt_pk_bf16(st[2 * s][2], st[2 * s][3]);
        pw.z = cvt_pk_bf16(st[2 * s + 1][0], st[2 * s + 1][1]); pw.w = cvt_pk_bf16(st[2 * s + 1][2], st[2 * s + 1][3]);
        bf16x8 pf; __builtin_memcpy(&pf, &pw, 16);
#pragma unroll
        for (int dt = 0; dt < 4; ++dt) { if (!UPFRONT) vf[s][dt] = vptr(16 * dt + fr, s); o[dt] = __builtin_amdgcn_mfma_f32_16x16x32_bf16(vf[s][dt], pf, o[dt], 0, 0, 0); }
    }
    const float inv = 1.0f / sum;
#pragma unroll
    for (int dt = 0; dt < 4; ++dt) { u32x2 w; w.x = cvt_pk_bf16(o[dt][0] * inv, o[dt][1] * inv); w.y = cvt_pk_bf16(o[dt][2] * inv, o[dt][3] * inv);
        *(u32x2*)(outp + 16 * dt + 4 * fq) = w; }
    __builtin_amdgcn_sched_barrier(0);
}

__device__ __forceinline__ void memattn_phase(const bf16_t* proj, int ldp, int mq_off, const bf16_t* mk, const bf16_t* mvt, bf16_t* mix, unsigned* ctr, unsigned char* lds, int tid, int bx) {
    const int lane = tid & 63, wave = tid >> 6, fr = lane & 15, fq = lane >> 4;
    volatile unsigned* slot = (volatile unsigned*)(lds + LDS_BYTES - 64);
    const unsigned char* kimg = lds; const unsigned char* vimg = lds + 32768;
    for (;;) {
        __syncthreads();
        if (tid == 0) *slot = __hip_atomic_fetch_add(ctr, 1u, __ATOMIC_RELAXED, __HIP_MEMORY_SCOPE_AGENT);
        __syncthreads();
        const int task = (int)*slot;
        if (task >= 256) break;
        const int oct = task & 7, h = (task >> 3) & 3, b = task >> 5;
#pragma unroll
        for (int k = 0; k < 4; ++k) { const int id = tid + 512 * k;
            { const int row = id >> 3, ch = id & 7, g = ((row >> 1) & 1) | (((row >> 3) & 1) << 1) | (((row >> 4) & 1) << 2);
              *(u32x4*)(lds + row * 128 + ((ch ^ g) << 4)) = *(const u32x4*)(mk + (size_t)(b * 256 + row) * 256 + h * 64 + ch * 8); }
            { const int d = id >> 5, ch = id & 31;
              *(u32x4*)(lds + 32768 + d * 512 + ((ch ^ (d & 15)) << 4)) = *(const u32x4*)(mvt + (size_t)(h * 64 + d) * 2048 + b * 256 + ch * 8); } }
        __syncthreads();
        bf16x8 qn[2];
        { const bf16_t* qp = proj + (size_t)(b * SEQ + oct * 512 + wave * 16 + fr) * ldp + mq_off + h * 64; qn[0] = *(const bf16x8*)(qp + 8 * fq); qn[1] = *(const bf16x8*)(qp + 32 + 8 * fq); }
        for (int g8 = 0; g8 < 4; ++g8) {
            int fqx = fq; asm volatile("" : "+v"(fqx));
            const int tok = b * SEQ + oct * 512 + g8 * 128 + wave * 16 + fr;
            bf16x8 qf[2]; qf[0] = qn[0]; qf[1] = qn[1];
            if (g8 < 3) { const bf16_t* qp = proj + (size_t)(tok + 128) * ldp + mq_off + h * 64; qn[0] = *(const bf16x8*)(qp + 8 * fq); qn[1] = *(const bf16x8*)(qp + 32 + 8 * fq); }
            attn16<false>(qf,
                   [&](int key, int ks) { const int g = ((key >> 1) & 1) | (((key >> 3) & 1) << 1) | (((key >> 4) & 1) << 2); return *(const bf16x8*)(kimg + key * 128 + (((4 * ks + fqx) ^ g) << 4)); },
                   [&](int d, int s) { return *(const bf16x8*)(vimg + d * 512 + (((4 * s + fqx) ^ (d & 15)) << 4)); },
                   [&](float v, int, int, int) { return v * 0.125f; },
                   mix + (size_t)tok * 1024 + 768 + h * 64, fr, fq);
        }
    }
    __syncthreads();
}

constexpr int NA_VOFF = 576 * 128, NA_VP = 1184, NA_ROFF = NA_VOFF + 64 * NA_VP;
__device__ __forceinline__ void na_phase(const bf16_t* proj, const bf16_t* vT, const float* rpb, bf16_t* mix, unsigned char* lds, int tid, int bx) {
    const int lane = tid & 63, wave = tid >> 6, fr = lane & 15, fq = lane >> 4;
    const float* lrp = (const float*)(lds + NA_ROFF);
    const int G = gridDim.x; const bool xl = (G % 8 == 0) && (G >= 8);
    const int nper = xl ? G / 8 : G, w0 = xl ? bx >> 3 : bx, nrun = xl ? 96 : 768;
    const int cb = wave & 3, kstart = clampi(cb * 16 - 8, 0, 32), qcol = cb * 16 + fr, wstart = clampi(qcol - 8, 0, 48);
    const int rsel = __builtin_amdgcn_readfirstlane(wave >> 2);
    unsigned dcp[4] = {0u, 0u, 0u, 0u};
#pragma unroll
    for (int jj = 0; jj < 8; ++jj) { const int kcol = kstart + 8 * fq + jj; const unsigned dv = (kcol >= wstart && kcol < wstart + 16) ? (unsigned)clampi(kcol - qcol + 15, 0, 30) : 480u; dcp[jj >> 1] |= dv << (16 * (jj & 1)); }
    for (int run = w0; run < nrun; run += nper) {
        const int b = xl ? (bx & 7) : run / 96, r2 = xl ? run : run % 96;
        const int h = r2 % 12, q4 = r2 / 12;
        const bf16_t* kgb = proj + (size_t)(b * SEQ) * LDN + 768 + h * 64;
        const bf16_t* vgb = vT + (size_t)(h * 64) * MTOK + b * SEQ;
        int hi = -1;
        for (int i4 = 0; i4 < 4; ++i4) {
            const int rp2 = 4 * q4 + i4;
            const int R0 = clampi(2 * rp2 - 4, 0, 56), need_hi = R0 + 8 < 63 ? R0 + 8 : 63;
            const int nlo = hi + 1 > R0 ? hi + 1 : R0, nr = need_hi - nlo + 1;
            const int r = 2 * rp2 + rsel, rs = clampi(r - 4, 0, 56);
            const int tok = b * SEQ + r * 64 + qcol;
            const bf16_t* qpe = proj + (size_t)tok * LDN + h * 64;
            bf16x8 qfe[2];
            __syncthreads();
            {
                u32x4 kq[9], vq[9];
                const int t8 = tid >> 3, c8 = tid & 7;
#pragma unroll
                for (int k = 0; k < 9; ++k) if (k < nr) { const int rho = nlo + k;
                    kq[k] = *(const u32x4*)(kgb + (size_t)(rho * 64 + t8) * LDN + c8 * 8);
                    vq[k] = *(const u32x4*)(vgb + (size_t)t8 * MTOK + rho * 64 + c8 * 8); }
                qfe[0] = *(const bf16x8*)(qpe + 8 * fq); qfe[1] = *(const bf16x8*)(qpe + 32 + 8 * fq);
                if (i4 == 0) { if (tid < 465) ((float*)(lds + NA_ROFF))[tid] = rpb[h * 465 + tid]; ((float*)(lds + NA_ROFF))[465 + tid] = -1.0e30f; }
#pragma unroll
                for (int k = 0; k < 9; ++k) if (k < nr) { const int slot = (nlo + k) % 9;
                    const int kk = slot * 64 + t8, g = ((kk >> 1) & 1) | (((kk >> 3) & 1) << 1) | (((kk >> 4) & 1) << 2);
                    *(u32x4*)(lds + kk * 128 + ((c8 ^ g) << 4)) = kq[k];
                    *(u32x4*)(lds + NA_VOFF + t8 * NA_VP + (slot * 8 + c8) * 16) = vq[k]; }
            }
            hi = need_hi;
            __syncthreads();
            int fqx = fq; asm volatile("" : "+v"(fqx));
            int sl[8];
#pragma unroll
            for (int q = 0; q < 8; ++q) sl[q] = (rs + q) % 9;
            bf16x8 qf[2]; qf[0] = qfe[0]; qf[1] = qfe[1];
            const float* rp = lrp + (rs - r + 7) * 31;
            const int gk = ((fr >> 1) & 1) | ((((kstart >> 3) + (fr >> 2)) & 3) << 1);
            const unsigned char* kimg = lds + (kstart + 8 * (fr >> 2) + (fr & 3)) * 128;
            const unsigned char* vimg = lds + NA_VOFF + ((kstart >> 3) + fqx) * 16;
            attn16<false>(qf,
                   [&](int key, int ks) { return *(const bf16x8*)(kimg + sl[key >> 5] * 8192 + ((key >> 2) & 1) * 512 + (((4 * ks + fqx) ^ gk) << 4)); },
                   [&](int d, int s) { return *(const bf16x8*)(vimg + d * NA_VP + sl[s] * 128); },
                   [&](float v, int s, int pp, int rr) { const int ix = pp * 4 + rr; const unsigned dc = (ix & 1) ? (dcp[ix >> 1] >> 16) : (dcp[ix >> 1] & 0xffffu); return v * 0.125f + rp[s * 31 + dc]; },
                   mix + (size_t)tok * 1024 + h * 64, fr, fq);
        }
    }
    __syncthreads();
}

constexpr int LP = 136;
constexpr int ST_OFF = 2 * 128 * LP * 2;
constexpr int SCAN_BUF = (128 + 64) * LP;
__device__ __forceinline__ void ret_scan(const bf16_t* proj, const float* cosT, const float* sinT, const float* decay, bf16_t* states, unsigned char* lds, int tid, int bx) {
    bf16_t* kT = (bf16_t*)lds;
    bf16_t* vTl = kT + 128 * LP;
    const int lane = tid & 63, wave = tid >> 6, fr = lane & 15, fq = lane >> 4;
    const int cp = tid >> 3, p8 = tid & 7, c0 = 2 * cp, et = wave >> 1, dbase = 4 * (wave & 1), cw = c0 ^ ((p8 & 3) << 4);
    for (int task = bx; task < 192; task += gridDim.x) {
        const int half = task & 1, dir = (task >> 1) & 1, bh = task >> 2, b = bh / 6, h = bh % 6;
        const float lg2 = -__expf(decay[dir * 6 + h]) * 1.4426950408889634f;
        const float cdec = exp2f(lg2 * 128.0f);
        const float wdec0 = exp2f(lg2 * (float)(dir == 0 ? 127 - c0 : c0)) * 0.08838834764831845f, wdec1 = exp2f(lg2 * (float)(dir == 0 ? 126 - c0 : c0 + 1)) * 0.08838834764831845f;
        f32x4 acc[4];
#pragma unroll
        for (int dt = 0; dt < 4; ++dt) acc[dt] = (f32x4){0.f, 0.f, 0.f, 0.f};
        u32x4 ka0A, kb0A, ka1A, kb1A, v0A, v1A, ka0B, kb0B, ka1B, kb1B, v0B, v1B; float4 csA[8], csB[8];
#define SCAN_NCH(st) (dir == 0 ? (st) : 31 - (st))
#define SCAN_LOAD(X, nn) do { const int t_ = (nn) * 128 + c0; const size_t row_ = (size_t)(b * SEQ + t_) * LDR; \
            const bf16_t* kp_ = proj + row_ + 768 + h * 128 + 8 * p8; ka0##X = *(const u32x4*)kp_; kb0##X = *(const u32x4*)(kp_ + 64); ka1##X = *(const u32x4*)(kp_ + LDR); kb1##X = *(const u32x4*)(kp_ + LDR + 64); \
            const bf16_t* vp_ = proj + row_ + 1536 + h * 128 + 64 * half + 8 * p8; v0##X = *(const u32x4*)vp_; v1##X = *(const u32x4*)(vp_ + LDR); \
            const float* cp_ = cosT + t_ * 64 + 8 * p8; const float* sp_ = sinT + t_ * 64 + 8 * p8; \
            cs##X[0] = *(const float4*)cp_; cs##X[1] = *(const float4*)(cp_ + 4); cs##X[2] = *(const float4*)sp_; cs##X[3] = *(const float4*)(sp_ + 4); \
            cs##X[4] = *(const float4*)(cp_ + 64); cs##X[5] = *(const float4*)(cp_ + 68); cs##X[6] = *(const float4*)(sp_ + 64); cs##X[7] = *(const float4*)(sp_ + 68); } while (0)
#define SCAN_WRITE(X, BUF) do { \
            const float co0[8] = {cs##X[0].x, cs##X[0].y, cs##X[0].z, cs##X[0].w, cs##X[1].x, cs##X[1].y, cs##X[1].z, cs##X[1].w}, si0[8] = {cs##X[2].x, cs##X[2].y, cs##X[2].z, cs##X[2].w, cs##X[3].x, cs##X[3].y, cs##X[3].z, cs##X[3].w}; \
            const float co1[8] = {cs##X[4].x, cs##X[4].y, cs##X[4].z, cs##X[4].w, cs##X[5].x, cs##X[5].y, cs##X[5].z, cs##X[5].w}, si1[8] = {cs##X[6].x, cs##X[6].y, cs##X[6].z, cs##X[6].w, cs##X[7].x, cs##X[7].y, cs##X[7].z, cs##X[7].w}; \
            const unsigned a0w[4] = {ka0##X.x, ka0##X.y, ka0##X.z, ka0##X.w}, b0w[4] = {kb0##X.x, kb0##X.y, kb0##X.z, kb0##X.w}, a1w[4] = {ka1##X.x, ka1##X.y, ka1##X.z, ka1##X.w}, b1w[4] = {kb1##X.x, kb1##X.y, kb1##X.z, kb1##X.w}; \
            const unsigned v0w[4] = {v0##X.x, v0##X.y, v0##X.z, v0##X.w}, v1w[4] = {v1##X.x, v1##X.y, v1##X.z, v1##X.w}; \
            unsigned* kT32 = (unsigned*)(kT + (BUF) * SCAN_BUF + (8 * p8) * LP + cw); unsigned* vT32 = (unsigned*)(vTl + (BUF) * SCAN_BUF + (8 * p8) * LP + cw); \
            _Pragma("unroll") for (int j = 0; j < 8; ++j) { \
                const float x10 = (j & 1) ? bf_hi(a0w[j >> 1]) : bf_lo(a0w[j >> 1]), x20 = (j & 1) ? bf_hi(b0w[j >> 1]) : bf_lo(b0w[j >> 1]); \
                const float x11 = (j & 1) ? bf_hi(a1w[j >> 1]) : bf_lo(a1w[j >> 1]), x21 = (j & 1) ? bf_hi(b1w[j >> 1]) : bf_lo(b1w[j >> 1]); \
                kT32[j * (LP / 2)] = cvt_pk_bf16(x10 * co0[j] - x20 * si0[j], x11 * co1[j] - x21 * si1[j]); \
                kT32[(64 + j) * (LP / 2)] = cvt_pk_bf16(x10 * si0[j] + x20 * co0[j], x11 * si1[j] + x21 * co1[j]); \
                const float vv0 = (j & 1) ? bf_hi(v0w[j >> 1]) : bf_lo(v0w[j >> 1]), vv1 = (j & 1) ? bf_hi(v1w[j >> 1]) : bf_lo(v1w[j >> 1]); \
                vT32[j * (LP / 2)] = cvt_pk_bf16(vv0 * wdec0, vv1 * wdec1); \
            } } while (0)
#define SCAN_MMA(BUF) do { \
            _Pragma("unroll") for (int kh = 0; kh < 4; kh += 2) { bf16x8 bfr[2], af[2][4]; \
                _Pragma("unroll") for (int u = 0; u < 2; ++u) { const int ks = kh + u; \
                    bfr[u] = *(const bf16x8*)(vTl + (BUF) * SCAN_BUF + (16 * et + fr) * LP + ((32 * ks + 8 * fq) ^ (((2 * et + (fr >> 3)) & 3) << 4))); \
                    _Pragma("unroll") for (int dt = 0; dt < 4; ++dt) af[u][dt] = *(const bf16x8*)(kT + (BUF) * SCAN_BUF + (16 * (dbase + dt) + fr) * LP + ((32 * ks + 8 * fq) ^ (((2 * (dbase + dt) + (fr >> 3)) & 3) << 4))); } \
                _Pragma("unroll") for (int u = 0; u < 2; ++u) \
                    _Pragma("unroll") for (int dt = 0; dt < 4; ++dt) acc[dt] = __builtin_amdgcn_mfma_f32_16x16x32_bf16(af[u][dt], bfr[u], acc[dt], 0, 0, 0); \
            } } while (0)
#define SCAN_STORE(st) do { \
            bf16_t* sp = states + ((size_t)((bh * 2 + dir) * 32 + SCAN_NCH(st))) * 16384 + (64 * half + 16 * et + fr) * 128 + 16 * dbase + 4 * fq; \
            _Pragma("unroll") for (int dt = 0; dt < 4; ++dt) { u32x2 w; w.x = cvt_pk_bf16(acc[dt][0], acc[dt][1]); w.y = cvt_pk_bf16(acc[dt][2], acc[dt][3]); *(u32x2*)(sp + 16 * dt) = w; } } while (0)
#define SCAN_BAR() do { asm volatile("s_waitcnt lgkmcnt(0)" ::: "memory"); __builtin_amdgcn_s_barrier(); asm volatile("" ::: "memory"); } while (0)
        SCAN_LOAD(A, SCAN_NCH(0)); SCAN_LOAD(B, SCAN_NCH(1));
        SCAN_WRITE(A, 0);
        SCAN_LOAD(A, SCAN_NCH(2));
        SCAN_BAR();
        for (int step = 0; step < 30; step += 2) {
            SCAN_STORE(step);
#pragma unroll
            for (int dt = 0; dt < 4; ++dt) acc[dt] *= cdec;
            SCAN_WRITE(B, 1); if (step + 3 <= 30) SCAN_LOAD(B, SCAN_NCH(step + 3));
            SCAN_MMA(0);
            SCAN_BAR();
            SCAN_STORE(step + 1);
#pragma unroll
            for (int dt = 0; dt < 4; ++dt) acc[dt] *= cdec;
            SCAN_WRITE(A, 0); if (step + 4 <= 30) SCAN_LOAD(A, SCAN_NCH(step + 4));
            SCAN_MMA(1);
            SCAN_BAR();
        }
        SCAN_STORE(30);
#pragma unroll
        for (int dt = 0; dt < 4; ++dt) acc[dt] *= cdec;
        SCAN_MMA(0);
        SCAN_STORE(31);
#undef SCAN_WRITE
#undef SCAN_MMA
#undef SCAN_STORE
#undef SCAN_BAR
#undef SCAN_NCH
#undef SCAN_LOAD
        __syncthreads();
    }
}

__device__ __forceinline__ void ret_out(const bf16_t* proj, const float* cosT, const float* sinT, const float* decay, const float* gn_g, const float* gn_b,
                        const bf16_t* states, bf16_t* mix, unsigned char* lds, int tid, int bx) {
    bf16_t* Kl = (bf16_t*)lds;
    bf16_t* Vl = Kl + 128 * LP;
    LAS unsigned char* ldsl = (LAS unsigned char*)lds;
    const int wave = __builtin_amdgcn_readfirstlane(tid >> 6);
    float* gnl = (float*)(lds + ST_OFF + 65536);
    for (int i = tid; i < 768; i += 512) { gnl[i] = gn_g[i]; gnl[768 + i] = gn_b[i]; }
    for (int task = bx; task < 1536; task += gridDim.x) {
        int tl = tid; asm volatile("" : "+v"(tl));
        const int lane = tl & 63, fr = lane & 15, fq = lane >> 4, c = tl >> 2, part = tl & 3, cw = c ^ (part << 4);
        const int n = task & 31, bh = task >> 5, b = bh / 6, h = bh % 6;
        const float lgf2 = -__expf(decay[h]) * 1.4426950408889634f, lgb2 = -__expf(decay[6 + h]) * 1.4426950408889634f;
        const int cq = 16 * wave + fr, tq = n * 128 + cq; const size_t rowq = (size_t)(b * SEQ + tq) * LDR;
        __syncthreads();
        {
            const char* spb = (const char*)(states + ((size_t)(bh * 2) * 32 + n) * 16384);
#pragma unroll
            for (int dir = 0; dir < 2; ++dir)
#pragma unroll
                for (int q4 = 0; q4 < 4; ++q4) { const int pc = wave + 8 * q4, e = 4 * pc + (lane >> 4), ch = (lane & 15) ^ (e & 15);
                    __builtin_amdgcn_global_load_lds((const unsigned*)(spb + (size_t)dir * (32 * 16384 * 2) + e * 256 + ch * 16), (LAS unsigned*)(ldsl + ST_OFF + dir * 32768 + pc * 1024), 16, 0, 0); }
        }
        u32x4 qr[4]; float4 qc[2][2], qs[2][2];
        { const bf16_t* qp = proj + rowq + h * 128 + 8 * fq;
#pragma unroll
          for (int ks = 0; ks < 4; ++ks) qr[ks] = *(const u32x4*)(qp + 32 * ks);
#pragma unroll
          for (int k2 = 0; k2 < 2; ++k2) { const float* cp = cosT + tq * 64 + 32 * k2 + 8 * fq; const float* snp = sinT + tq * 64 + 32 * k2 + 8 * fq;
              qc[k2][0] = *(const float4*)cp; qc[k2][1] = *(const float4*)(cp + 4); qs[k2][0] = *(const float4*)snp; qs[k2][1] = *(const float4*)(snp + 4); } }
        {
            const int t = n * 128 + c; const size_t row = (size_t)(b * SEQ + t) * LDR;
            const bf16_t* kp = proj + row + 768 + h * 128 + 16 * part;
            const u32x4 k1a = *(const u32x4*)kp, k1b = *(const u32x4*)(kp + 8), k2a = *(const u32x4*)(kp + 64), k2b = *(const u32x4*)(kp + 72);
            const float* cp = cosT + t * 64 + 16 * part; const float* snp = sinT + t * 64 + 16 * part;
            const int cpv = tl >> 3, p8v = tl & 7, c0v = 2 * cpv;
            const bf16_t* vp = proj + (size_t)(b * SEQ + n * 128 + c0v) * LDR + 1536 + h * 128 + 16 * p8v;
            u32x4 vv[4];
            vv[0] = *(const u32x4*)vp; vv[1] = *(const u32x4*)(vp + 8); vv[2] = *(const u32x4*)(vp + LDR); vv[3] = *(const u32x4*)(vp + LDR + 8);
            float cs[16], sn[16];
#pragma unroll
            for (int q4 = 0; q4 < 4; ++q4) { const float4 cv = *(const float4*)(cp + 4 * q4), sv = *(const float4*)(snp + 4 * q4);
                cs[4 * q4] = cv.x; cs[4 * q4 + 1] = cv.y; cs[4 * q4 + 2] = cv.z; cs[4 * q4 + 3] = cv.w; sn[4 * q4] = sv.x; sn[4 * q4 + 1] = sv.y; sn[4 * q4 + 2] = sv.z; sn[4 * q4 + 3] = sv.w; }
            const unsigned k1w[8] = {k1a.x, k1a.y, k1a.z, k1a.w, k1b.x, k1b.y, k1b.z, k1b.w}, k2w[8] = {k2a.x, k2a.y, k2a.z, k2a.w, k2b.x, k2b.y, k2b.z, k2b.w};
            unsigned r1[8], r2[8];
#pragma unroll
            for (int w2 = 0; w2 < 8; ++w2) {
                const float a1 = bf_lo(k1w[w2]), b1 = bf_hi(k1w[w2]), a2 = bf_lo(k2w[w2]), b2 = bf_hi(k2w[w2]);
                r1[w2] = cvt_pk_bf16(a1 * cs[2 * w2] - a2 * sn[2 * w2], b1 * cs[2 * w2 + 1] - b2 * sn[2 * w2 + 1]);
                r2[w2] = cvt_pk_bf16(a1 * sn[2 * w2] + a2 * cs[2 * w2], b1 * sn[2 * w2 + 1] + b2 * cs[2 * w2 + 1]);
            }
            *(u32x4*)(Kl + c * LP + 16 * part) = (u32x4){r1[0], r1[1], r1[2], r1[3]}; *(u32x4*)(Kl + c * LP + 16 * part + 8) = (u32x4){r1[4], r1[5], r1[6], r1[7]};
            *(u32x4*)(Kl + c * LP + 64 + 16 * part) = (u32x4){r2[0], r2[1], r2[2], r2[3]}; *(u32x4*)(Kl + c * LP + 64 + 16 * part + 8) = (u32x4){r2[4], r2[5], r2[6], r2[7]};
            { const unsigned t0w[8] = {vv[0].x, vv[0].y, vv[0].z, vv[0].w, vv[1].x, vv[1].y, vv[1].z, vv[1].w}, t1w[8] = {vv[2].x, vv[2].y, vv[2].z, vv[2].w, vv[3].x, vv[3].y, vv[3].z, vv[3].w};
              unsigned* V32 = (unsigned*)(Vl + (16 * p8v) * LP + (c0v ^ ((p8v & 3) << 4)));
#pragma unroll
              for (int j = 0; j < 16; ++j) { const unsigned x0 = (j & 1) ? (t0w[j >> 1] >> 16) : (t0w[j >> 1] & 0xffffu), x1 = (j & 1) ? (t1w[j >> 1] & 0xffff0000u) : (t1w[j >> 1] << 16);
                  V32[j * (LP / 2)] = x0 | x1; } }
        }
        asm volatile("s_waitcnt vmcnt(0)" ::: "memory");
        __syncthreads();
        u32x2 gwv[8];
        { const bf16_t* gp0 = proj + rowq + 2304 + h * 128 + 4 * fq;
#pragma unroll
          for (int e8 = 0; e8 < 8; ++e8) gwv[e8] = *(const u32x2*)(gp0 + 16 * e8); }
        bf16x8 qf[4];
#pragma unroll
        for (int k2 = 0; k2 < 2; ++k2) {
            const float cs[8] = {qc[k2][0].x, qc[k2][0].y, qc[k2][0].z, qc[k2][0].w, qc[k2][1].x, qc[k2][1].y, qc[k2][1].z, qc[k2][1].w};
            const float sn[8] = {qs[k2][0].x, qs[k2][0].y, qs[k2][0].z, qs[k2][0].w, qs[k2][1].x, qs[k2][1].y, qs[k2][1].z, qs[k2][1].w};
            const unsigned x1w[4] = {qr[k2].x, qr[k2].y, qr[k2].z, qr[k2].w}, x2w[4] = {qr[k2 + 2].x, qr[k2 + 2].y, qr[k2 + 2].z, qr[k2 + 2].w};
            unsigned o1[4], o2[4];
#pragma unroll
            for (int w2 = 0; w2 < 4; ++w2) { const float a1 = bf_lo(x1w[w2]), b1 = bf_hi(x1w[w2]), a2 = bf_lo(x2w[w2]), b2 = bf_hi(x2w[w2]);
                o1[w2] = cvt_pk_bf16(a1 * cs[2 * w2] - a2 * sn[2 * w2], b1 * cs[2 * w2 + 1] - b2 * sn[2 * w2 + 1]);
                o2[w2] = cvt_pk_bf16(a1 * sn[2 * w2] + a2 * cs[2 * w2], b1 * sn[2 * w2 + 1] + b2 * cs[2 * w2 + 1]); }
            const u32x4 p1 = (u32x4){o1[0], o1[1], o1[2], o1[3]}, p2 = (u32x4){o2[0], o2[1], o2[2], o2[3]};
            __builtin_memcpy(&qf[k2], &p1, 16); __builtin_memcpy(&qf[k2 + 2], &p2, 16);
        }
        bf16x8 pf[4];
#pragma unroll
        for (int s = 0; s < 4; ++s) {
            f32x4 st2[2];
#pragma unroll
            for (int pp = 0; pp < 2; ++pp) {
                const bf16_t* kr = Kl + (32 * s + 8 * (fr >> 2) + 4 * pp + (fr & 3)) * LP + 8 * fq;
                f32x4 a = (f32x4){0.f, 0.f, 0.f, 0.f};
#pragma unroll
                for (int ks = 0; ks < 4; ++ks) a = __builtin_amdgcn_mfma_f32_16x16x32_bf16(*(const bf16x8*)(kr + 32 * ks), qf[ks], a, 0, 0, 0);
#pragma unroll
                for (int r = 0; r < 4; ++r) { const int sk = 32 * s + 8 * fq + 4 * pp + r, diff = cq - sk;
                    const float df = (float)diff;
                    const float dd = __builtin_amdgcn_exp2f(fminf(lgf2 * df, -lgb2 * df)) + fmaxf(1.0f - fabsf(df), 0.0f);
                    a[r] *= dd * 0.08838834764831845f; }
                st2[pp] = a;
            }
            const u32x4 pw = (u32x4){cvt_pk_bf16(st2[0][0], st2[0][1]), cvt_pk_bf16(st2[0][2], st2[0][3]), cvt_pk_bf16(st2[1][0], st2[1][1]), cvt_pk_bf16(st2[1][2], st2[1][3])};
            __builtin_memcpy(&pf[s], &pw, 16);
        }
        f32x4 acc[8];
#pragma unroll
        for (int e8 = 0; e8 < 8; ++e8) acc[e8] = (f32x4){0.f, 0.f, 0.f, 0.f};
#pragma unroll
        for (int s = 0; s < 4; ++s)
#pragma unroll
            for (int e8 = 0; e8 < 8; ++e8) acc[e8] = __builtin_amdgcn_mfma_f32_16x16x32_bf16(*(const bf16x8*)(Vl + (16 * e8 + fr) * LP + ((32 * s + 8 * fq) ^ ((e8 & 3) << 4))), pf[s], acc[e8], 0, 0, 0);
#pragma unroll
        for (int dir = 0; dir < 2; ++dir) {
            const unsigned char* sl = lds + ST_OFF + dir * 32768 + fr * 256;
            const float sc = dir == 0 ? __builtin_amdgcn_exp2f(lgf2 * (float)(cq + 1)) : __builtin_amdgcn_exp2f(lgb2 * (float)(128 - cq));
#pragma unroll
            for (int e8 = 0; e8 < 8; ++e8) {
                f32x4 a2 = (f32x4){0.f, 0.f, 0.f, 0.f};
#pragma unroll
                for (int ks = 0; ks < 4; ++ks) a2 = __builtin_amdgcn_mfma_f32_16x16x32_bf16(*(const bf16x8*)(sl + e8 * 4096 + (((4 * ks + fq) ^ fr) << 4)), qf[ks], a2, 0, 0, 0);
                acc[e8] += a2 * sc;
            }
        }
        float sm = 0.f;
#pragma unroll
        for (int e8 = 0; e8 < 8; ++e8) sm += (acc[e8][0] + acc[e8][1]) + (acc[e8][2] + acc[e8][3]);
        sm += __shfl_xor(sm, 16); sm += __shfl_xor(sm, 32);
        const float mu = sm * (1.0f / 128.0f);
        float vs = 0.f;
#pragma unroll
        for (int e8 = 0; e8 < 8; ++e8)
#pragma unroll
            for (int r = 0; r < 4; ++r) { const float dlt = acc[e8][r] - mu; vs += dlt * dlt; }
        vs += __shfl_xor(vs, 16); vs += __shfl_xor(vs, 32);
        const float rstd = 1.0f / sqrtf(vs * (1.0f / 128.0f) + 1e-5f);
        bf16_t* op = mix + (size_t)(b * SEQ + tq) * 1024 + h * 128 + 4 * fq;
#pragma unroll
        for (int e8 = 0; e8 < 8; ++e8) {
            const u32x2 gw = gwv[e8];
            const float4 gg = *(const float4*)(gnl + h * 128 + 16 * e8 + 4 * fq), gb = *(const float4*)(gnl + 768 + h * 128 + 16 * e8 + 4 * fq);
            const float y0 = ((acc[e8][0] - mu) * rstd * gg.x + gb.x) * silu_f(bf_lo(gw.x));
            const float y1 = ((acc[e8][1] - mu) * rstd * gg.y + gb.y) * silu_f(bf_hi(gw.x));
            const float y2 = ((acc[e8][2] - mu) * rstd * gg.z + gb.z) * silu_f(bf_lo(gw.y));
            const float y3 = ((acc[e8][3] - mu) * rstd * gg.w + gb.w) * silu_f(bf_hi(gw.y));
            u32x2 w; w.x = cvt_pk_bf16(y0, y1); w.y = cvt_pk_bf16(y2, y3);
            *(u32x2*)(op + 16 * e8) = w;
        }
    }
    __syncthreads();
}

#define XB_TMO      128
#define XB_XCNT(j)  (256  + 64 * (j))
#define XB_XSUB(j)  (1280 + 64 * (j))
#define XB_XGEN(j)  (2304 + 64 * (j))
#define XB_TOP      3328
#define XB_TOPGEN   3392
#define XCD_BAR_WORDS 3456
#define XB_SPIN_CAP (1u << 18)
__device__ __forceinline__ unsigned xb_ld(unsigned* p)              { return __hip_atomic_load(p, __ATOMIC_RELAXED, __HIP_MEMORY_SCOPE_AGENT); }
__device__ __forceinline__ unsigned xb_add(unsigned* p, unsigned v) { return __hip_atomic_fetch_add(p, v, __ATOMIC_RELAXED, __HIP_MEMORY_SCOPE_AGENT); }
__device__ __forceinline__ unsigned xb_xcc_id() { return (unsigned)__builtin_amdgcn_s_getreg((3 << 11) | 20) & 0xFu; }
#define XB_SPIN(cond, bar) do { unsigned _sp = 0; while (cond) { __builtin_amdgcn_s_sleep(1); \
    if ((++_sp & 255u) == 0u) { if (xb_ld(&(bar)[XB_TMO])) break; if (_sp > XB_SPIN_CAP) { atomicAdd(&(bar)[XB_TMO], 1u); break; } } } } while (0)
struct XcdBarrier { unsigned* bar; unsigned x; volatile LAS unsigned* st; };
__device__ __forceinline__ XcdBarrier xcd_barrier_post(unsigned* bar, volatile LAS unsigned* st) {
    XcdBarrier b; b.bar = bar; b.x = xb_xcc_id(); b.st = st;
    if (threadIdx.x == 0) (void)xb_add(&bar[XB_XCNT(b.x)], 1u);
    return b;
}
__device__ __forceinline__ void xcd_barrier_complete(unsigned* bar, unsigned x, unsigned& nloc, unsigned& nx) {
    const unsigned G = gridDim.x * gridDim.y * gridDim.z;
    unsigned sum, cnt, mine, sp = 0u;
    for (;;) {
        sum = 0u; cnt = 0u; mine = 0u;
#pragma unroll
        for (unsigned j = 0; j < 16; ++j) { const unsigned c = xb_ld(&bar[XB_XCNT(j)]); sum += c; cnt += (c > 0u) ? 1u : 0u; mine = (j == x) ? c : mine; }
        if (sum == G) break;
        __builtin_amdgcn_s_sleep(1);
        if ((++sp & 255u) == 0u) { if (xb_ld(&bar[XB_TMO])) break; if (sp > XB_SPIN_CAP) { atomicAdd(&bar[XB_TMO], 1u); break; } }
    }
    nloc = mine > 0u ? mine : 1u; nx = cnt > 0u ? cnt : 1u;
}
__device__ __forceinline__ void xcd_barrier(const XcdBarrier& b, bool leader) {
    asm volatile("s_waitcnt vmcnt(0)" ::: "memory");
    __syncthreads();
    if (leader) {
        unsigned* bar = b.bar;
        __builtin_amdgcn_s_waitcnt(0);
        unsigned nloc = b.st[0], nx = b.st[1];
        if (nloc == 0u) { xcd_barrier_complete(bar, b.x, nloc, nx); b.st[0] = nloc; b.st[1] = nx; }
        const unsigned old = xb_add(&bar[XB_XSUB(b.x)], 1u);
        const unsigned gen = old / nloc;
        if (old + 1u == (gen + 1u) * nloc) {
            __builtin_amdgcn_fence(__ATOMIC_RELEASE, "agent");
            asm volatile("s_waitcnt vmcnt(0)" ::: "memory");
            const unsigned og = xb_add(&bar[XB_TOP], 1u);
            const unsigned tg = og / nx;
            if (og + 1u == (tg + 1u) * nx) xb_add(&bar[XB_TOPGEN], 1u);
            else XB_SPIN(xb_ld(&bar[XB_TOPGEN]) == tg, bar);
            __builtin_amdgcn_fence(__ATOMIC_ACQUIRE, "agent");
            xb_add(&bar[XB_XGEN(b.x)], 1u);
            asm volatile("s_waitcnt vmcnt(0)" ::: "memory");
        } else {
            XB_SPIN(xb_ld(&bar[XB_XGEN(b.x)]) == gen, bar);
            __builtin_amdgcn_fence(__ATOMIC_ACQUIRE, "agent");
            asm volatile("s_waitcnt vmcnt(0)" ::: "memory");
        }
    }
    __syncthreads();
}

constexpr int N_PH = 33;
__host__ __device__ inline bool phase_exists(int ph) { if (ph == 0) return true; const int i = (ph - 1) >> 3, s = (ph - 1) & 7; return !((i & 1) && s == 1); }

__device__ __forceinline__ int fresh_tid(int wave_s) { int t = wave_s * 64 + (int)__builtin_amdgcn_mbcnt_hi(~0u, __builtin_amdgcn_mbcnt_lo(~0u, 0u)); asm volatile("" : "+v"(t)); return t; }
__global__ void __launch_bounds__(512, 2) mega(Params p) {
    extern __shared__ __attribute__((aligned(16))) unsigned char lds[];
    LAS unsigned char* ldsl = (LAS unsigned char*)lds;
    const int G = gridDim.x;
    volatile LAS unsigned* xst = (volatile LAS unsigned*)(ldsl + LDS_BYTES - 16);
    if (threadIdx.x < 4) xst[threadIdx.x] = 0u;
    __syncthreads();
    const XcdBarrier xbar = xcd_barrier_post((unsigned*)(p.ws + WS_BAR), xst);
#define abuf ((bf16_t*)(wsp + WS_ABUF))
#define r1 ((bf16_t*)(wsp + WS_R1))
#define mix ((bf16_t*)(wsp + WS_MIX))
#define Wb ((bf16_t*)(wsp + WS_W))
#define states ((bf16_t*)(wsp + WS_ST))
#define memw ((bf16_t*)(wsp + WS_MEMW))
#define memn ((bf16_t*)(wsp + WS_MEMN))
#define mkv ((bf16_t*)(wsp + WS_MKV))
#define mvt ((bf16_t*)(wsp + WS_MVT))
#define cosT ((float*)(wsp + WS_COS))
#define sinT ((float*)(wsp + WS_SIN))
#define vT (r1 + (size_t)MTOK * LDN)
    const int ph_lo = p.ph_lo, ph_hi = p.ph_hi;
    const int wave_s = __builtin_amdgcn_readfirstlane((int)(threadIdx.x >> 6));
#define tid fresh_tid(wave_s)
#define PHASE_IDS() int bx = blockIdx.x; asm volatile("" : "+s"(bx)); \
        kargp_t ka = (kargp_t)__builtin_amdgcn_kernarg_segment_ptr(); asm volatile("" : "+s"(ka)); unsigned char* const wsp = KARG(unsigned char*, ws)
    if (ph_lo == 0) {
        PHASE_IDS();
            wconv(KARG(const float*, mem_w_kv), 1024, 512, memw, 0, lds, tid, bx);
            rownorm_first(KARG(const float*, x), KARG(const float*, norm_g), abuf, MTOK, tid, bx);
            rownorm_first(KARG(const float*, mem), KARG(const float*, mem_norm_g), memn, 2048, tid, bx);
            rope_table(cosT, sinT, tid, bx);
        conv_layer_weights(ka, 0, lds, tid, bx);
        if (ph_hi > 4096) cg::this_grid().sync();
        else if (ph_hi > 1) xcd_barrier(xbar, tid == 0);
    }
    for (int ph = ph_lo > 1 ? ph_lo : 1; ph < ph_hi; ++ph) {
        if (!phase_exists(ph)) continue;
        PHASE_IDS();
        {
            const int i = (ph - 1) >> 3, s = (ph - 1) & 7, j = i >> 1; const bool ret = !(i & 1);
            const float* ng = KARG(const float*, norm_g) + (size_t)i * 4 * 1024;
            const int ng_gemm = (s == 0) ? (ret ? (i == 0 ? 3 : 1) : 2) : ((s == 3 || s == 6) ? 1 : 0);
            for (int gi = 0; gi < ng_gemm; ++gi) {
                pg8::Gemm g; bf16_t* o; int ld;
                if (s == 0) {
                    if (gi == 0)      { g = pg8::Gemm{abuf, Wb + W_IN_OFF, MTOK, ret ? LDR : LDN, 1024}; o = r1; ld = ret ? LDR : LDN; }
                    else if (!ret)    { g = pg8::Gemm{Wb + W_IN_OFF + (size_t)LDN * 1024, abuf, 768, MTOK, 1024}; o = vT; ld = MTOK; }
                    else if (gi == 1) { g = pg8::Gemm{memn, memw, 2048, 256, 1024}; o = mkv; ld = 256; }
                    else              { g = pg8::Gemm{memw + (size_t)256 * 1024, memn, 256, 2048, 1024}; o = mvt; ld = 2048; }
                } else if (s == 3)    { g = pg8::Gemm{mix, Wb + W_OUT_OFF, MTOK, 1024, 1024}; o = abuf; ld = 1024; }
                else                  { g = pg8::Gemm{r1, Wb + W_F2_OFF, MTOK, 1024, FF}; o = abuf; ld = 1024; }
                const int off = gi == 0 ? 0 : (gi == 1 ? G / 2 : G / 2 + 8);
                pg8::StaticOrder S; S.init(g.M, g.N, G, (bx + G - off) % G);
                pg8::EpiBf16 E{o, ld};
                pg8::gemm_phase<pg8::EpiBf16, pg8::StaticOrder>(ldsl, g, S, E, tid);
            }
            if (s == 5) { pg8::Gemm g{abuf, Wb + W_F1_OFF, MTOK, 2 * FF, 1024}; pg8::StaticOrder S; S.init(g.M, g.N, G, bx);
                pg8::EpiSwiglu E{r1, FF}; pg8::gemm_phase<pg8::EpiSwiglu, pg8::StaticOrder>(ldsl, g, S, E, tid); }
            if (s == 1) ret_scan(r1, cosT, sinT, KARG(const float*, ret_decay) + j * 12, states, lds, tid, bx);
            if (s == 2) {
                if (ret) ret_out(r1, cosT, sinT, KARG(const float*, ret_decay) + j * 12, KARG(const float*, ret_gn_g) + j * 768, KARG(const float*, ret_gn_b) + j * 768, states, mix, lds, tid, bx);
                else     na_phase(r1, vT, KARG(const float*, na_rpb) + (size_t)j * 12 * 465, mix, lds, tid, bx);
            }
            if ((ret && s == 1) || (!ret && s == 2)) memattn_phase(r1, ret ? LDR : LDN, ret ? 3072 : 1536, mkv, mvt, mix, (unsigned*)(wsp + WS_BAR) + 3584 + 64 * i, lds, tid, bx);
            if (s == 4 || s == 7) rowpass(abuf, (i == 0 && s == 4) ? KARG(const float*, x) : KARG(float*, out), KARG(float*, out), ng + (s == 4 ? 1024 : 3072), s == 4 ? ng + 2048 : (i < 3 ? ng + 4096 : nullptr), abuf, tid, bx);

        }
        if (ph >= 8 && ph < 32 && ((ph - 1) & 7) == 7) conv_layer_weights(ka, ((ph - 1) >> 3) + 1, lds, tid, bx);
        if (ph + 1 < ph_hi) xcd_barrier(xbar, tid == 0);
    }
}

#undef PHASE_IDS
#undef tid
#undef abuf
#undef r1
#undef mix
#undef Wb
#undef states
#undef memw
#undef memn
#undef mkv
#undef mvt
#undef cosT
#undef sinT
#undef vT
extern "C" void kernel_launch(void* const* d_in, const int* in_sizes, int n_in, void* d_out, int out_size, void* d_ws, size_t ws_size, hipStream_t stream) {
    static int grid = 0;
    if (grid == 0) {
        if (n_in != 15 || out_size != MTOK * DM || ws_size < WS_END) { fprintf(stderr, "kernel_launch: unexpected shapes (n_in %d out %d ws %zu need %zu)\n", n_in, out_size, ws_size, (size_t)WS_END); grid = -1; return; }
        int dev = 0, cus = 0, per_cu = 0;
        hipGetDevice(&dev); hipDeviceGetAttribute(&cus, hipDeviceAttributeMultiprocessorCount, dev);
        hipFuncSetAttribute((const void*)mega, hipFuncAttributeMaxDynamicSharedMemorySize, LDS_BYTES);
        hipOccupancyMaxActiveBlocksPerMultiprocessor(&per_cu, (const void*)mega, 512, LDS_BYTES);
        if (per_cu < 1) per_cu = 1;
        if (per_cu > 1) per_cu = 1;
        (void)hipGetLastError();
        grid = cus * per_cu;
    }
    if (grid < 0) return;
    if (hipMemsetAsync((char*)d_ws + WS_BAR, 0, 16384, stream) != hipSuccess) fprintf(stderr, "kernel_launch: memset of barrier words failed\n");
    Params p{};
    p.x = (const float*)d_in[0]; p.mem = (const float*)d_in[1]; p.norm_g = (const float*)d_in[2]; p.mem_norm_g = (const float*)d_in[3]; p.mem_w_kv = (const float*)d_in[4];
    p.ret_w_in = (const float*)d_in[5]; p.ret_w_out = (const float*)d_in[6]; p.ret_gn_g = (const float*)d_in[7]; p.ret_gn_b = (const float*)d_in[8]; p.ret_decay = (const float*)d_in[9];
    p.na_w_in = (const float*)d_in[10]; p.na_w_out = (const float*)d_in[11]; p.na_rpb = (const float*)d_in[12]; p.ffn_w_in = (const float*)d_in[13]; p.ffn_w_out = (const float*)d_in[14];
    p.out = (float*)d_out; p.ws = (unsigned char*)d_ws;
#if ONE_LAUNCH
    p.ph_lo = 0; p.ph_hi = N_PH;
    void* args[] = {&p};
    hipError_t e = hipLaunchCooperativeKernel((const void*)mega, dim3(grid), dim3(512), args, LDS_BYTES, stream);
    if (e != hipSuccess) fprintf(stderr, "cooperative launch failed: %s (grid %d)\n", hipGetErrorString(e), grid);
#else
    for (int ph = 0; ph < N_PH; ++ph) { if (!phase_exists(ph)) continue; p.ph_lo = ph; p.ph_hi = ph + 1;
        hipLaunchKernelGGL(mega, dim3(grid), dim3(512), LDS_BYTES, stream, p); }
#endif
}
```

```cpp
#include <hip/hip_runtime.h>
#include <hip/hip_cooperative_groups.h>
#include <cstdio>
namespace cg = cooperative_groups;

#ifndef ONE_LAUNCH
#define ONE_LAUNCH 1
#endif

#define LAS __attribute__((address_space(3)))
typedef unsigned short bf16_t;
typedef short bf16x8 __attribute__((ext_vector_type(8)));
typedef float f32x4 __attribute__((ext_vector_type(4)));
typedef unsigned u32x4 __attribute__((ext_vector_type(4)));
typedef unsigned u32x2 __attribute__((ext_vector_type(2)));

constexpr int MTOK = 32768, DM = 1024, SEQ = 4096, NB = 8;
constexpr int LDR = 3328;
constexpr int LDN = 1792;
constexpr int FF = 2816;
constexpr int LDS_BYTES = 163840;

constexpr size_t WS_ABUF = 0;
constexpr size_t WS_R1   = WS_ABUF + (size_t)MTOK * 1024 * 2;
constexpr size_t WS_MIX  = WS_R1 + (size_t)MTOK * LDR * 2;
constexpr size_t WS_W    = WS_MIX + (size_t)MTOK * 1024 * 2;
constexpr size_t W_IN_OFF = 0, W_OUT_OFF = (size_t)3328 * 1024, W_F1_OFF = W_OUT_OFF + (size_t)1024 * 1024, W_F2_OFF = W_F1_OFF + (size_t)5632 * 1024, W_ELEMS = W_F2_OFF + (size_t)1024 * FF;
constexpr size_t WS_ST   = WS_W + W_ELEMS * 2;
constexpr size_t WS_MEMW = WS_ST + (size_t)48 * 2 * 32 * 16384 * 2;
constexpr size_t WS_MEMN = WS_MEMW + (size_t)512 * 1024 * 2;
constexpr size_t WS_MKV  = WS_MEMN + (size_t)2048 * 1024 * 2;
constexpr size_t WS_MVT  = WS_MKV + (size_t)2048 * 512 * 2;
constexpr size_t WS_COS  = WS_MVT + (size_t)2048 * 256 * 2;
constexpr size_t WS_SIN  = WS_COS + (size_t)4096 * 64 * 4;
constexpr size_t WS_BAR  = WS_SIN + (size_t)4096 * 64 * 4;
constexpr size_t WS_END  = WS_BAR + 16384;

typedef __bf16 bf16x2_t __attribute__((ext_vector_type(2)));
__device__ __forceinline__ unsigned cvt_pk_bf16(float lo, float hi) { bf16x2_t v; v[0] = (__bf16)lo; v[1] = (__bf16)hi; return __builtin_bit_cast(unsigned, v); }
__device__ __forceinline__ unsigned cvt_pk_bf16_nv(float lo, float hi) { return cvt_pk_bf16(lo, hi); }
__device__ __forceinline__ float bf_lo(unsigned u) { return __uint_as_float(u << 16); }
__device__ __forceinline__ float bf_hi(unsigned u) { return __uint_as_float(u & 0xffff0000u); }
__device__ __forceinline__ bf16_t f2bf(float f) { return (bf16_t)(cvt_pk_bf16(f, 0.f) & 0xffffu); }
__device__ __forceinline__ float silu_f(float x) { return x * __builtin_amdgcn_rcpf(1.0f + __expf(-x)); }
__device__ __forceinline__ int clampi(int v, int lo, int hi) { return v < lo ? lo : (v > hi ? hi : v); }

namespace pg8 {
constexpr int BM = 256, BK = 64, HALF = 128, HTB = HALF * BK * 2, STAGE_BYTES = 8 * HTB, NXCD = 8, WGM = 8;
__device__ __forceinline__ int lds_byte(int r, int c) { const int st = (r >> 4) * 2 + (c >> 5), rr = r & 15, cc = c & 31, ob = rr * 64 + cc * 2; return st * 1024 + (ob ^ (((ob >> 9) & 1) << 5)); }
__device__ __forceinline__ void stage_rc(int b, int& R, int& C) { const int st = b / 1024, sb = b % 1024, swz = sb ^ (((sb >> 9) & 1) << 5); R = (st >> 1) * 16 + swz / 64; C = (st & 1) * 32 + (swz % 64) / 2; }
__device__ __forceinline__ int perm32(int rho) { const int n = rho >> 4, i = rho & 15; return 8 * (i >> 2) + 4 * n + (i & 3); }
struct Unit { int pm, pn; };
struct Gemm { const bf16_t* A; const bf16_t* Bt; int M, N, K; };
struct StaticOrder {
    int nM, nN, nwg, G, c;
    __device__ void init(int M, int N, int G_, int c_) { nM = M / BM; nN = N / BM; nwg = nM * nN; G = G_; c = c_; }
    __device__ bool next(int i, Unit& u) const {
        const long L = (long)i * G + c; if (L >= nwg) return false;
        int wgid = (int)L; { const int q = nwg / NXCD, r = nwg % NXCD, xcd = wgid % NXCD, off = wgid / NXCD; wgid = (xcd < r ? xcd * (q + 1) : r * (q + 1) + (xcd - r) * q) + off; }
        const int nig = WGM * nN, gid = wgid / nig, fm = gid * WGM, gsz = (nM - fm) < WGM ? (nM - fm) : WGM;
        u.pm = fm + ((wgid % nig) % gsz); u.pn = (wgid % nig) / gsz; return true;
    }
};
struct EpiBf16 {
    static constexpr bool PERM = true;
    bf16_t* O; int ldc;
    __device__ __forceinline__ void operator()(const f32x4 (&acc)[2][2][4][2], const Unit& u, int wr, int wc, int fr, int fq) const {
        const int row0 = u.pm * BM + wr * 64 + fr, col0 = u.pn * BM + wc * 32 + 8 * fq;
#pragma unroll
        for (int ai = 0; ai < 2; ++ai)
#pragma unroll
            for (int m = 0; m < 4; ++m) { bf16_t* rowp = O + (size_t)(row0 + ai * HALF + m * 16) * ldc + col0;
#pragma unroll
                for (int bj = 0; bj < 2; ++bj) { const f32x4 v0 = acc[ai][bj][m][0], v1 = acc[ai][bj][m][1];
                    u32x4 w; w.x = cvt_pk_bf16(v0[0], v0[1]); w.y = cvt_pk_bf16(v0[2], v0[3]); w.z = cvt_pk_bf16(v1[0], v1[1]); w.w = cvt_pk_bf16(v1[2], v1[3]);
                    *(u32x4*)(rowp + bj * HALF) = w; } }
    }
};
struct EpiSwiglu {
    static constexpr bool PERM = true;
    bf16_t* O; int ldc;
    __device__ __forceinline__ void operator()(const f32x4 (&acc)[2][2][4][2], const Unit& u, int wr, int wc, int fr, int fq) const {
        const int row0 = u.pm * BM + wr * 64 + fr, col0 = u.pn * HALF + wc * 32 + 8 * fq;
#pragma unroll
        for (int ai = 0; ai < 2; ++ai)
#pragma unroll
            for (int m = 0; m < 4; ++m) { bf16_t* rowp = O + (size_t)(row0 + ai * HALF + m * 16) * ldc + col0;
                float h[8], ex[8];
#pragma unroll
                for (int q = 0; q < 8; ++q) ex[q] = __builtin_amdgcn_exp2f(acc[ai][0][m][q >> 2][q & 3] * -1.4426950408889634f);
#pragma unroll
                for (int q = 0; q < 8; ++q) ex[q] = __builtin_amdgcn_rcpf(1.0f + ex[q]);
#pragma unroll
                for (int q = 0; q < 8; ++q) h[q] = (acc[ai][0][m][q >> 2][q & 3] * acc[ai][1][m][q >> 2][q & 3]) * ex[q];
                u32x4 w; w.x = cvt_pk_bf16_nv(h[0], h[1]); w.y = cvt_pk_bf16_nv(h[2], h[3]); w.z = cvt_pk_bf16_nv(h[4], h[5]); w.w = cvt_pk_bf16_nv(h[6], h[7]);
                *(u32x4*)rowp = w; }
    }
};

template <class Epi, class Sched>
__device__ __forceinline__ void gemm_phase(LAS unsigned char* lds, const Gemm g, const Sched& S, const Epi& E, int tid) {
    const int wid = __builtin_amdgcn_readfirstlane(tid >> 6), lane = tid & 63, wr = wid >> 2, wc = wid & 3, fr = lane & 15, fq = lane >> 4;
    const int K = g.K, nt = K / BK;
    unsigned voffA[2], voffB[2];
#pragma unroll
    for (int i = 0; i < 2; ++i) { int R, C; stage_rc(tid * 16 + i * 8192, R, C); const int Rb = Epi::PERM ? ((R & ~31) + perm32(R & 31)) : R;
        voffA[i] = (unsigned)(R * K + C) * 2u; voffB[i] = (unsigned)(Rb * K + C) * 2u; }
    const size_t kstep = (size_t)(BK * 2);
    const size_t hstep = (size_t)HALF * K * 2;
    const size_t tstep = 2 * hstep;
    const unsigned ldsw = (unsigned)wid * 1024u;
    const int aoff = lds_byte(wr * 64 + fr, fq * 8), boff = lds_byte(wc * 32 + fr, fq * 8);
#define PG8_SA(b, h) (((b) * 2 + (h)) * HTB)
#define PG8_SB(b, h) ((4 + (b) * 2 + (h)) * HTB)
#define PG8_STAGE(bufoff, gbase, voff) do { _Pragma("unroll") for (int _i = 0; _i < 2; ++_i) \
        __builtin_amdgcn_global_load_lds((const unsigned*)((const char*)(gbase) + (voff)[_i]), (LAS unsigned*)(lds + (bufoff) + ldsw + _i * 8192), 16, 0, 0); } while (0)
#define PG8_LDA(dst, b, h) do { _Pragma("unroll") for (int m = 0; m < 4; ++m) _Pragma("unroll") for (int k = 0; k < 2; ++k) dst[m][k] = *(const LAS bf16x8*)(lds + PG8_SA(b, h) + aoff + m * 2048 + k * 1024); } while (0)
#define PG8_LDB(dst, b, h) do { _Pragma("unroll") for (int n = 0; n < 2; ++n) _Pragma("unroll") for (int k = 0; k < 2; ++k) dst[n][k] = *(const LAS bf16x8*)(lds + PG8_SB(b, h) + boff + n * 2048 + k * 1024); } while (0)
#define PG8_MMA(ai, bj, At, Bt) do { __builtin_amdgcn_s_setprio(1); _Pragma("unroll") for (int m = 0; m < 4; ++m) _Pragma("unroll") for (int n = 0; n < 2; ++n) _Pragma("unroll") for (int k = 0; k < 2; ++k) \
        acc[ai][bj][m][n] = __builtin_amdgcn_mfma_f32_16x16x32_bf16(Bt[n][k], At[m][k], acc[ai][bj][m][n], 0, 0, 0); __builtin_amdgcn_s_setprio(0); } while (0)
#define PG8_WAIT_V(n) asm volatile("s_waitcnt vmcnt(" #n ")" ::: "memory")
#define PG8_WAIT_L(n) asm volatile("s_waitcnt lgkmcnt(" #n ")" ::: "memory")
#define PG8_BAR __builtin_amdgcn_s_barrier()
#define PG8_SCHED __builtin_amdgcn_sched_barrier(0)
    Unit cur, nxt; int ui = 0;
    if (!S.next(0, cur)) return;
    f32x4 acc[2][2][4][2];
#pragma unroll
    for (int a = 0; a < 2; ++a)
#pragma unroll
        for (int b = 0; b < 2; ++b)
#pragma unroll
            for (int m = 0; m < 4; ++m)
#pragma unroll
                for (int n = 0; n < 2; ++n) acc[a][b][m][n] = (f32x4){0.f, 0.f, 0.f, 0.f};
    bf16x8 At[4][2], B0[2][2], B1[2][2];
    const char* cA = (const char*)g.A + (size_t)cur.pm * tstep; const char* cB = (const char*)g.Bt + (size_t)cur.pn * tstep;
    PG8_STAGE(PG8_SB(0, 0), cB, voffB); PG8_STAGE(PG8_SA(0, 0), cA, voffA); PG8_STAGE(PG8_SB(0, 1), cB + hstep, voffB); PG8_STAGE(PG8_SA(0, 1), cA + hstep, voffA);
    if (wr == 1) PG8_BAR;
    PG8_WAIT_V(4); PG8_BAR;
    PG8_STAGE(PG8_SB(1, 0), cB + kstep, voffB); PG8_STAGE(PG8_SA(1, 0), cA + kstep, voffA); PG8_STAGE(PG8_SB(1, 1), cB + hstep + kstep, voffB);
    PG8_WAIT_V(6); PG8_BAR;
    for (;;) {
        const bool has_next = S.next(ui + 1, nxt);
        const char* nA = has_next ? (const char*)g.A + (size_t)nxt.pm * tstep : cA; const char* nB = has_next ? (const char*)g.Bt + (size_t)nxt.pn * tstep : cB;
        for (int t = 0; t < nt; t += 2) {
            const bool last = (t == nt - 2);
            const char* a1 = cA + (size_t)(t + 1) * kstep;
            const char* a2 = last ? nA : cA + (size_t)(t + 2) * kstep; const char* b2 = last ? nB : cB + (size_t)(t + 2) * kstep;
            const char* a3 = a2 + kstep; const char* b3 = b2 + kstep;
            PG8_LDB(B0, 0, 0); PG8_SCHED; PG8_LDA(At, 0, 0); PG8_STAGE(PG8_SA(1, 1), a1 + hstep, voffA);
            PG8_WAIT_L(8); PG8_BAR; PG8_WAIT_L(0); PG8_MMA(0, 0, At, B0); PG8_BAR; PG8_SCHED;
            PG8_LDB(B1, 0, 1); PG8_STAGE(PG8_SB(0, 0), b2, voffB);
            PG8_BAR; PG8_WAIT_L(0); PG8_MMA(0, 1, At, B1); PG8_BAR;
            PG8_LDA(At, 0, 1); PG8_STAGE(PG8_SA(0, 0), a2, voffA);
            PG8_BAR; PG8_WAIT_L(0); PG8_MMA(1, 0, At, B0); PG8_BAR; PG8_SCHED;
            PG8_STAGE(PG8_SB(0, 1), b2 + hstep, voffB);
            PG8_WAIT_V(6); PG8_BAR; PG8_MMA(1, 1, At, B1); PG8_BAR;
            PG8_LDB(B0, 1, 0); PG8_SCHED; PG8_LDA(At, 1, 0); PG8_STAGE(PG8_SA(0, 1), a2 + hstep, voffA);
            PG8_WAIT_L(8); PG8_BAR; PG8_WAIT_L(0); PG8_MMA(0, 0, At, B0); PG8_BAR; PG8_SCHED;
            PG8_LDB(B1, 1, 1); PG8_STAGE(PG8_SB(1, 0), b3, voffB);
            PG8_BAR; PG8_WAIT_L(0); PG8_MMA(0, 1, At, B1); PG8_BAR;
            PG8_LDA(At, 1, 1); PG8_STAGE(PG8_SA(1, 0), a3, voffA);
            PG8_BAR; PG8_WAIT_L(0); PG8_MMA(1, 0, At, B0); PG8_BAR; PG8_SCHED;
            PG8_STAGE(PG8_SB(1, 1), b3 + hstep, voffB);
            PG8_WAIT_V(6); PG8_BAR; PG8_MMA(1, 1, At, B1); PG8_BAR;
        }
        E(acc, cur, wr, wc, fr, fq);
        if (!has_next) break;
#pragma unroll
        for (int a = 0; a < 2; ++a)
#pragma unroll
            for (int b = 0; b < 2; ++b)
#pragma unroll
                for (int m = 0; m < 4; ++m)
#pragma unroll
                    for (int n = 0; n < 2; ++n) acc[a][b][m][n] = (f32x4){0.f, 0.f, 0.f, 0.f};
        cur = nxt; cA = nA; cB = nB; ++ui;
    }
    PG8_WAIT_V(0);
    if (wr == 0) PG8_BAR;
    PG8_BAR;
#undef PG8_SA
#undef PG8_SB
#undef PG8_STAGE
#undef PG8_LDA
#undef PG8_LDB
#undef PG8_MMA
#undef PG8_WAIT_V
#undef PG8_WAIT_L
#undef PG8_BAR
#undef PG8_SCHED
}
}

struct Params {
    const float* x; const float* mem; const float* norm_g; const float* mem_norm_g; const float* mem_w_kv;
    const float* ret_w_in; const float* ret_w_out; const float* ret_gn_g; const float* ret_gn_b; const float* ret_decay;
    const float* na_w_in; const float* na_w_out; const float* na_rpb; const float* ffn_w_in; const float* ffn_w_out;
    float* out; unsigned char* ws; int ph_lo, ph_hi;
};

typedef const __attribute__((address_space(4))) char* kargp_t;
#define KARG(T, field) (*(T const __attribute__((address_space(4)))*)(ka + __builtin_offsetof(Params, field)))
__device__ __forceinline__ int wsrc(int mode, int n0) {
    if (mode == 1) { const int pn = n0 >> 8, bj = (n0 >> 7) & 1, c0 = n0 & 127; return bj * FF + 128 * pn + c0; }
    if (mode == 2) { return n0 < 1536 ? n0 : (n0 < 1792 ? n0 + 768 : n0 - 256); }
    return n0;
}
__device__ __forceinline__ void wconv(const float* W, int K, int N, bf16_t* Bt, int mode, unsigned char* lds, int tid, int bx) {
    float* tile = (float*)lds;
    const int nkt = K / 128, ntiles = nkt * (N / 64);
    for (int t = bx; t < ntiles; t += gridDim.x) {
        const int kt = t % nkt, nt = t / nkt, n0 = nt * 64, k0 = kt * 128, s0 = wsrc(mode, n0);
        const int r = tid >> 4, c4 = (tid & 15) * 4;
        float4 v[4];
#pragma unroll
        for (int hh = 0; hh < 4; ++hh) v[hh] = *(const float4*)(W + (size_t)(k0 + r + hh * 32) * N + s0 + c4);
        __syncthreads();
#pragma unroll
        for (int hh = 0; hh < 4; ++hh) { const int rr = r + hh * 32; tile[rr * 65 + c4] = v[hh].x; tile[rr * 65 + c4 + 1] = v[hh].y; tile[rr * 65 + c4 + 2] = v[hh].z; tile[rr * 65 + c4 + 3] = v[hh].w; }
        __syncthreads();
        { const int j = tid >> 3, i0 = (tid & 7) * 16; float x[16];
#pragma unroll
          for (int ii = 0; ii < 16; ++ii) x[ii] = tile[(i0 + ii) * 65 + j];
          u32x4 w0, w1; w0.x = cvt_pk_bf16(x[0], x[1]); w0.y = cvt_pk_bf16(x[2], x[3]); w0.z = cvt_pk_bf16(x[4], x[5]); w0.w = cvt_pk_bf16(x[6], x[7]);
          w1.x = cvt_pk_bf16(x[8], x[9]); w1.y = cvt_pk_bf16(x[10], x[11]); w1.z = cvt_pk_bf16(x[12], x[13]); w1.w = cvt_pk_bf16(x[14], x[15]);
          bf16_t* dst = Bt + (size_t)(n0 + j) * K + k0 + i0; *(u32x4*)dst = w0; *(u32x4*)(dst + 8) = w1; }
    }
    __syncthreads();
}
__device__ __forceinline__ void conv_layer_weights(kargp_t ka, int i, unsigned char* lds, int tid, int bx) {
    bf16_t* Wb = (bf16_t*)(KARG(unsigned char*, ws) + WS_W); const int j = i >> 1;
    if (!(i & 1)) { wconv(KARG(const float*, ret_w_in) + (size_t)j * 1024 * 3328, 1024, 3328, Wb + W_IN_OFF, 0, lds, tid, bx); wconv(KARG(const float*, ret_w_out) + (size_t)j * 1024 * 1024, 1024, 1024, Wb + W_OUT_OFF, 0, lds, tid, bx); }
    else          { wconv(KARG(const float*, na_w_in) + (size_t)j * 1024 * 2560, 1024, 2560, Wb + W_IN_OFF, 2, lds, tid, bx);  wconv(KARG(const float*, na_w_out) + (size_t)j * 1024 * 1024, 1024, 1024, Wb + W_OUT_OFF, 0, lds, tid, bx); }
    wconv(KARG(const float*, ffn_w_in) + (size_t)i * 1024 * 5632, 1024, 5632, Wb + W_F1_OFF, 1, lds, tid, bx);
    wconv(KARG(const float*, ffn_w_out) + (size_t)i * FF * 1024, FF, 1024, Wb + W_F2_OFF, 0, lds, tid, bx);
}

__device__ __forceinline__ float wave_sum(float v) {
#pragma unroll
    for (int o = 32; o >= 1; o >>= 1) v += __shfl_xor(v, o);
    return v;
}
__device__ __forceinline__ void rownorm_first(const float* x, const float* g, bf16_t* a, int nrows, int tid, int bx) {
    const int lane = tid & 63, wave = tid >> 6;
    for (int row = bx * 8 + wave; row < nrows; row += gridDim.x * 8) {
        float4 v[4]; float ss = 0.f;
#pragma unroll
        for (int i = 0; i < 4; ++i) { v[i] = *(const float4*)(x + (size_t)row * 1024 + i * 256 + lane * 4); ss += v[i].x * v[i].x + v[i].y * v[i].y + v[i].z * v[i].z + v[i].w * v[i].w; }
        ss = wave_sum(ss); const float rs = 1.0f / sqrtf(ss * (1.0f / 1024.0f) + 1e-6f);
#pragma unroll
        for (int i = 0; i < 4; ++i) { const float4 gg = *(const float4*)(g + i * 256 + lane * 4);
            u32x2 w; w.x = cvt_pk_bf16(v[i].x * rs * gg.x, v[i].y * rs * gg.y); w.y = cvt_pk_bf16(v[i].z * rs * gg.z, v[i].w * rs * gg.w);
            *(u32x2*)(a + (size_t)row * 1024 + i * 256 + lane * 4) = w; }
    }
}
__device__ __forceinline__ void rowpass(const bf16_t* y, const float* hin, float* hout, const float* g1, const float* g2, bf16_t* a, int tid, int bx) {
    const int lane = tid & 63, wave = tid >> 6;
    for (int row0 = (bx * 8 + wave) * 2; row0 < MTOK; row0 += gridDim.x * 16) {
        u32x2 yw[2][4]; float4 h[2][4];
#pragma unroll
        for (int u = 0; u < 2; ++u)
#pragma unroll
            for (int i = 0; i < 4; ++i) { yw[u][i] = *(const u32x2*)(y + (size_t)(row0 + u) * 1024 + i * 256 + lane * 4); { const f32x4 t4 = __builtin_nontemporal_load((const f32x4*)(hin + (size_t)(row0 + u) * 1024 + i * 256 + lane * 4)); h[u][i] = make_float4(t4[0], t4[1], t4[2], t4[3]); } }
        float4 ga[4];
#pragma unroll
        for (int i = 0; i < 4; ++i) ga[i] = *(const float4*)(g1 + i * 256 + lane * 4);
        float yv[2][4][4]; float ss[2] = {0.f, 0.f};
#pragma unroll
        for (int u = 0; u < 2; ++u)
#pragma unroll
            for (int i = 0; i < 4; ++i) { yv[u][i][0] = bf_lo(yw[u][i].x); yv[u][i][1] = bf_hi(yw[u][i].x); yv[u][i][2] = bf_lo(yw[u][i].y); yv[u][i][3] = bf_hi(yw[u][i].y);
                ss[u] += yv[u][i][0] * yv[u][i][0] + yv[u][i][1] * yv[u][i][1] + yv[u][i][2] * yv[u][i][2] + yv[u][i][3] * yv[u][i][3]; }
#pragma unroll
        for (int o = 32; o >= 1; o >>= 1) { ss[0] += __shfl_xor(ss[0], o); ss[1] += __shfl_xor(ss[1], o); }
        float ss2[2] = {0.f, 0.f};
#pragma unroll
        for (int u = 0; u < 2; ++u) { const float rs = 1.0f / sqrtf(ss[u] * (1.0f / 1024.0f) + 1e-6f);
#pragma unroll
            for (int i = 0; i < 4; ++i) {
                h[u][i].x += yv[u][i][0] * rs * ga[i].x; h[u][i].y += yv[u][i][1] * rs * ga[i].y; h[u][i].z += yv[u][i][2] * rs * ga[i].z; h[u][i].w += yv[u][i][3] * rs * ga[i].w;
                __builtin_nontemporal_store((f32x4){h[u][i].x, h[u][i].y, h[u][i].z, h[u][i].w}, (f32x4*)(hout + (size_t)(row0 + u) * 1024 + i * 256 + lane * 4));
                ss2[u] += h[u][i].x * h[u][i].x + h[u][i].y * h[u][i].y + h[u][i].z * h[u][i].z + h[u][i].w * h[u][i].w; } }
        if (g2) {
#pragma unroll
            for (int o = 32; o >= 1; o >>= 1) { ss2[0] += __shfl_xor(ss2[0], o); ss2[1] += __shfl_xor(ss2[1], o); }
#pragma unroll
            for (int i = 0; i < 4; ++i) ga[i] = *(const float4*)(g2 + i * 256 + lane * 4);
#pragma unroll
            for (int u = 0; u < 2; ++u) { const float rs2 = 1.0f / sqrtf(ss2[u] * (1.0f / 1024.0f) + 1e-6f);
#pragma unroll
                for (int i = 0; i < 4; ++i) { u32x2 w; w.x = cvt_pk_bf16(h[u][i].x * rs2 * ga[i].x, h[u][i].y * rs2 * ga[i].y); w.y = cvt_pk_bf16(h[u][i].z * rs2 * ga[i].z, h[u][i].w * rs2 * ga[i].w);
                    *(u32x2*)(a + (size_t)(row0 + u) * 1024 + i * 256 + lane * 4) = w; } }
        }
    }
}
__device__ __forceinline__ void rope_table(float* cosT, float* sinT, int tid, int bx) {
    for (int idx = bx * 512 + tid; idx < SEQ * 64; idx += gridDim.x * 512) {
        const int t = idx >> 6, i = idx & 63;
        const float inv = exp2f(-(float)i * (13.287712379549449f / 64.0f));
        const float ang = (float)t * inv;
        double rv = (double)ang * 0.15915494309189535; rv -= rint(rv);
        cosT[idx] = __builtin_amdgcn_cosf((float)rv); sinT[idx] = __builtin_amdgcn_sinf((float)rv);
    }
}
template <bool UPFRONT, class KP, class VP, class MOD>
__device__ __forceinline__ void attn16(const bf16x8 (&qf)[2], KP kptr, VP vptr, MOD mod, bf16_t* outp  , int fr, int fq) {
    bf16x8 kf[16][2];
#pragma unroll
    for (int t = 0; t < 16; ++t) if (UPFRONT) { const int key = 32 * (t >> 1) + 8 * (fr >> 2) + 4 * (t & 1) + (fr & 3); kf[t][0] = kptr(key, 0); kf[t][1] = kptr(key, 1); }
    f32x4 st[16];
    float mx = -3.0e38f;
#pragma unroll
    for (int t = 0; t < 16; ++t) {
        f32x4 acc = (f32x4){0.f, 0.f, 0.f, 0.f};
        if (!UPFRONT) { const int key = 32 * (t >> 1) + 8 * (fr >> 2) + 4 * (t & 1) + (fr & 3); kf[t][0] = kptr(key, 0); kf[t][1] = kptr(key, 1); }
        acc = __builtin_amdgcn_mfma_f32_16x16x32_bf16(kf[t][0], qf[0], acc, 0, 0, 0);
        acc = __builtin_amdgcn_mfma_f32_16x16x32_bf16(kf[t][1], qf[1], acc, 0, 0, 0);
#pragma unroll
        for (int r = 0; r < 4; ++r) { const float v = mod(acc[r], t >> 1, t & 1, r); acc[r] = v; mx = fmaxf(mx, v); }
        st[t] = acc;
    }
    __builtin_amdgcn_sched_barrier(0);
    bf16x8 vf[8][4];
#pragma unroll
    for (int s = 0; s < 8; ++s)
#pragma unroll
        for (int dt = 0; dt < 4; ++dt) if (UPFRONT) vf[s][dt] = vptr(16 * dt + fr, s);
    mx = fmaxf(mx, __shfl_xor(mx, 16)); mx = fmaxf(mx, __shfl_xor(mx, 32));
    float sum = 0.f;
#pragma unroll
    for (int t = 0; t < 16; ++t)
#pragma unroll
        for (int r = 0; r < 4; ++r) { const float e = __expf(st[t][r] - mx); st[t][r] = e; sum += e; }
    sum += __shfl_xor(sum, 16); sum += __shfl_xor(sum, 32);
    f32x4 o[4];
#pragma unroll
    for (int dt = 0; dt < 4; ++dt) o[dt] = (f32x4){0.f, 0.f, 0.f, 0.f};
#pragma unroll
    for (int s = 0; s < 8; ++s) {
        u32x4 pw; pw.x = cvt_pk_bf16(st[2 * s][0], st[2 * s][1]); pw.y = cvt_pk_bf16(st[2 * s][2], st[2 * s][3]);
        pw.z = cvt_pk_bf16(st[2 * s + 1][0], st[2 * s + 1][1]); pw.w = cvt_pk_bf16(st[2 * s + 1][2], st[2 * s + 1][3]);
        bf16x8 pf; __builtin_memcpy(&pf, &pw, 16);
#pragma unroll
        for (int dt = 0; dt < 4; ++dt) { if (!UPFRONT) vf[s][dt] = vptr(16 * dt + fr, s); o[dt] = __builtin_amdgcn_mfma_f32_16x16x32_bf16(vf[s][dt], pf, o[dt], 0, 0, 0); }
    }
    const float inv = 1.0f / sum;
#pragma unroll
    for (int dt = 0; dt < 4; ++dt) { u32x2 w; w.x = cvt_pk_bf16(o[dt][0] * inv, o[dt][1] * inv); w.y = cvt_pk_bf16(o[dt][2] * inv, o[dt][3] * inv);
        *(u32x2*)(outp + 16 * dt + 4 * fq) = w; }
    __builtin_amdgcn_sched_barrier(0);
}

__device__ __forceinline__ void memattn_phase(const bf16_t* proj, int ldp, int mq_off, const bf16_t* mk, const bf16_t* mvt, bf16_t* mix, unsigned* ctr, unsigned char* lds, int tid, int bx) {
    const int lane = tid & 63, wave = tid >> 6, fr = lane & 15, fq = lane >> 4;
    volatile unsigned* slot = (volatile unsigned*)(lds + LDS_BYTES - 64);
    const unsigned char* kimg = lds; const unsigned char* vimg = lds + 32768;
    for (;;) {
        __syncthreads();
        if (tid == 0) *slot = __hip_atomic_fetch_add(ctr, 1u, __ATOMIC_RELAXED, __HIP_MEMORY_SCOPE_AGENT);
        __syncthreads();
        const int task = (int)*slot;
        if (task >= 256) break;
        const int oct = task & 7, h = (task >> 3) & 3, b = task >> 5;
#pragma unroll
        for (int k = 0; k < 4; ++k) { const int id = tid + 512 * k;
            { const int row = id >> 3, ch = id & 7, g = ((row >> 1) & 1) | (((row >> 3) & 1) << 1) | (((row >> 4) & 1) << 2);
              *(u32x4*)(lds + row * 128 + ((ch ^ g) << 4)) = *(const u32x4*)(mk + (size_t)(b * 256 + row) * 256 + h * 64 + ch * 8); }
            { const int d = id >> 5, ch = id & 31;
              *(u32x4*)(lds + 32768 + d * 512 + ((ch ^ (d & 15)) << 4)) = *(const u32x4*)(mvt + (size_t)(h * 64 + d) * 2048 + b * 256 + ch * 8); } }
        __syncthreads();
        bf16x8 qn[2];
        { const bf16_t* qp = proj + (size_t)(b * SEQ + oct * 512 + wave * 16 + fr) * ldp + mq_off + h * 64; qn[0] = *(const bf16x8*)(qp + 8 * fq); qn[1] = *(const bf16x8*)(qp + 32 + 8 * fq); }
        for (int g8 = 0; g8 < 4; ++g8) {
            int fqx = fq; asm volatile("" : "+v"(fqx));
            const int tok = b * SEQ + oct * 512 + g8 * 128 + wave * 16 + fr;
            bf16x8 qf[2]; qf[0] = qn[0]; qf[1] = qn[1];
            if (g8 < 3) { const bf16_t* qp = proj + (size_t)(tok + 128) * ldp + mq_off + h * 64; qn[0] = *(const bf16x8*)(qp + 8 * fq); qn[1] = *(const bf16x8*)(qp + 32 + 8 * fq); }
            attn16<false>(qf,
                   [&](int key, int ks) { const int g = ((key >> 1) & 1) | (((key >> 3) & 1) << 1) | (((key >> 4) & 1) << 2); return *(const bf16x8*)(kimg + key * 128 + (((4 * ks + fqx) ^ g) << 4)); },
                   [&](int d, int s) { return *(const bf16x8*)(vimg + d * 512 + (((4 * s + fqx) ^ (d & 15)) << 4)); },
                   [&](float v, int, int, int) { return v * 0.125f; },
                   mix + (size_t)tok * 1024 + 768 + h * 64, fr, fq);
        }
    }
    __syncthreads();
}

constexpr int NA_VOFF = 576 * 128, NA_VP = 1184, NA_ROFF = NA_VOFF + 64 * NA_VP;
__device__ __forceinline__ void na_phase(const bf16_t* proj, const bf16_t* vT, const float* rpb, bf16_t* mix, unsigned char* lds, int tid, int bx) {
    const int lane = tid & 63, wave = tid >> 6, fr = lane & 15, fq = lane >> 4;
    const float* lrp = (const float*)(lds + NA_ROFF);
    const int G = gridDim.x; const bool xl = (G % 8 == 0) && (G >= 8);
    const int nper = xl ? G / 8 : G, w0 = xl ? bx >> 3 : bx, nrun = xl ? 96 : 768;
    const int cb = wave & 3, kstart = clampi(cb * 16 - 8, 0, 32), qcol = cb * 16 + fr, wstart = clampi(qcol - 8, 0, 48);
    const int rsel = __builtin_amdgcn_readfirstlane(wave >> 2);
    unsigned dcp[4] = {0u, 0u, 0u, 0u};
#pragma unroll
    for (int jj = 0; jj < 8; ++jj) { const int kcol = kstart + 8 * fq + jj; const unsigned dv = (kcol >= wstart && kcol < wstart + 16) ? (unsigned)clampi(kcol - qcol + 15, 0, 30) : 480u; dcp[jj >> 1] |= dv << (16 * (jj & 1)); }
    for (int run = w0; run < nrun; run += nper) {
        const int b = xl ? (bx & 7) : run / 96, r2 = xl ? run : run % 96;
        const int h = r2 % 12, q4 = r2 / 12;
        const bf16_t* kgb = proj + (size_t)(b * SEQ) * LDN + 768 + h * 64;
        const bf16_t* vgb = vT + (size_t)(h * 64) * MTOK + b * SEQ;
        int hi = -1;
        for (int i4 = 0; i4 < 4; ++i4) {
            const int rp2 = 4 * q4 + i4;
            const int R0 = clampi(2 * rp2 - 4, 0, 56), need_hi = R0 + 8 < 63 ? R0 + 8 : 63;
            const int nlo = hi + 1 > R0 ? hi + 1 : R0, nr = need_hi - nlo + 1;
            const int r = 2 * rp2 + rsel, rs = clampi(r - 4, 0, 56);
            const int tok = b * SEQ + r * 64 + qcol;
            const bf16_t* qpe = proj + (size_t)tok * LDN + h * 64;
            bf16x8 qfe[2];
            __syncthreads();
            {
                u32x4 kq[9], vq[9];
                const int t8 = tid >> 3, c8 = tid & 7;
#pragma unroll
                for (int k = 0; k < 9; ++k) if (k < nr) { const int rho = nlo + k;
                    kq[k] = *(const u32x4*)(kgb + (size_t)(rho * 64 + t8) * LDN + c8 * 8);
                    vq[k] = *(const u32x4*)(vgb + (size_t)t8 * MTOK + rho * 64 + c8 * 8); }
                qfe[0] = *(const bf16x8*)(qpe + 8 * fq); qfe[1] = *(const bf16x8*)(qpe + 32 + 8 * fq);
                if (i4 == 0) { if (tid < 465) ((float*)(lds + NA_ROFF))[tid] = rpb[h * 465 + tid]; ((float*)(lds + NA_ROFF))[465 + tid] = -1.0e30f; }
#pragma unroll
                for (int k = 0; k < 9; ++k) if (k < nr) { const int slot = (nlo + k) % 9;
                    const int kk = slot * 64 + t8, g = ((kk >> 1) & 1) | (((kk >> 3) & 1) << 1) | (((kk >> 4) & 1) << 2);
                    *(u32x4*)(lds + kk * 128 + ((c8 ^ g) << 4)) = kq[k];
                    *(u32x4*)(lds + NA_VOFF + t8 * NA_VP + (slot * 8 + c8) * 16) = vq[k]; }
            }
            hi = need_hi;
            __syncthreads();
            int fqx = fq; asm volatile("" : "+v"(fqx));
            int sl[8];
#pragma unroll
            for (int q = 0; q < 8; ++q) sl[q] = (rs + q) % 9;
            bf16x8 qf[2]; qf[0] = qfe[0]; qf[1] = qfe[1];
            const float* rp = lrp + (rs - r + 7) * 31;
            const int gk = ((fr >> 1) & 1) | ((((kstart >> 3) + (fr >> 2)) & 3) << 1);
            const unsigned char* kimg = lds + (kstart + 8 * (fr >> 2) + (fr & 3)) * 128;
            const unsigned char* vimg = lds + NA_VOFF + ((kstart >> 3) + fqx) * 16;
            attn16<false>(qf,
                   [&](int key, int ks) { return *(const bf16x8*)(kimg + sl[key >> 5] * 8192 + ((key >> 2) & 1) * 512 + (((4 * ks + fqx) ^ gk) << 4)); },
                   [&](int d, int s) { return *(const bf16x8*)(vimg + d * NA_VP + sl[s] * 128); },
                   [&](float v, int s, int pp, int rr) { const int ix = pp * 4 + rr; const unsigned dc = (ix & 1) ? (dcp[ix >> 1] >> 16) : (dcp[ix >> 1] & 0xffffu); return v * 0.125f + rp[s * 31 + dc]; },
                   mix + (size_t)tok * 1024 + h * 64, fr, fq);
        }
    }
    __syncthreads();
}

constexpr int LP = 136;
constexpr int ST_OFF = 2 * 128 * LP * 2;
constexpr int SCAN_BUF = (128 + 64) * LP;
__device__ __forceinline__ void ret_scan(const bf16_t* proj, const float* cosT, const float* sinT, const float* decay, bf16_t* states, unsigned char* lds, int tid, int bx) {
    bf16_t* kT = (bf16_t*)lds;
    bf16_t* vTl = kT + 128 * LP;
    const int lane = tid & 63, wave = tid >> 6, fr = lane & 15, fq = lane >> 4;
    const int cp = tid >> 3, p8 = tid & 7, c0 = 2 * cp, et = wave >> 1, dbase = 4 * (wave & 1), cw = c0 ^ ((p8 & 3) << 4);
    for (int task = bx; task < 192; task += gridDim.x) {
        const int half = task & 1, dir = (task >> 1) & 1, bh = task >> 2, b = bh / 6, h = bh % 6;
        const float lg2 = -__expf(decay[dir * 6 + h]) * 1.4426950408889634f;
        const float cdec = exp2f(lg2 * 128.0f);
        const float wdec0 = exp2f(lg2 * (float)(dir == 0 ? 127 - c0 : c0)) * 0.08838834764831845f, wdec1 = exp2f(lg2 * (float)(dir == 0 ? 126 - c0 : c0 + 1)) * 0.08838834764831845f;
        f32x4 acc[4];
#pragma unroll
        for (int dt = 0; dt < 4; ++dt) acc[dt] = (f32x4){0.f, 0.f, 0.f, 0.f};
        u32x4 ka0A, kb0A, ka1A, kb1A, v0A, v1A, ka0B, kb0B, ka1B, kb1B, v0B, v1B; float4 csA[8], csB[8];
#define SCAN_NCH(st) (dir == 0 ? (st) : 31 - (st))
#define SCAN_LOAD(X, nn) do { const int t_ = (nn) * 128 + c0; const size_t row_ = (size_t)(b * SEQ + t_) * LDR; \
            const bf16_t* kp_ = proj + row_ + 768 + h * 128 + 8 * p8; ka0##X = *(const u32x4*)kp_; kb0##X = *(const u32x4*)(kp_ + 64); ka1##X = *(const u32x4*)(kp_ + LDR); kb1##X = *(const u32x4*)(kp_ + LDR + 64); \
            const bf16_t* vp_ = proj + row_ + 1536 + h * 128 + 64 * half + 8 * p8; v0##X = *(const u32x4*)vp_; v1##X = *(const u32x4*)(vp_ + LDR); \
            const float* cp_ = cosT + t_ * 64 + 8 * p8; const float* sp_ = sinT + t_ * 64 + 8 * p8; \
            cs##X[0] = *(const float4*)cp_; cs##X[1] = *(const float4*)(cp_ + 4); cs##X[2] = *(const float4*)sp_; cs##X[3] = *(const float4*)(sp_ + 4); \
            cs##X[4] = *(const float4*)(cp_ + 64); cs##X[5] = *(const float4*)(cp_ + 68); cs##X[6] = *(const float4*)(sp_ + 64); cs##X[7] = *(const float4*)(sp_ + 68); } while (0)
#define SCAN_WRITE(X, BUF) do { \
            const float co0[8] = {cs##X[0].x, cs##X[0].y, cs##X[0].z, cs##X[0].w, cs##X[1].x, cs##X[1].y, cs##X[1].z, cs##X[1].w}, si0[8] = {cs##X[2].x, cs##X[2].y, cs##X[2].z, cs##X[2].w, cs##X[3].x, cs##X[3].y, cs##X[3].z, cs##X[3].w}; \
            const float co1[8] = {cs##X[4].x, cs##X[4].y, cs##X[4].z, cs##X[4].w, cs##X[5].x, cs##X[5].y, cs##X[5].z, cs##X[5].w}, si1[8] = {cs##X[6].x, cs##X[6].y, cs##X[6].z, cs##X[6].w, cs##X[7].x, cs##X[7].y, cs##X[7].z, cs##X[7].w}; \
            const unsigned a0w[4] = {ka0##X.x, ka0##X.y, ka0##X.z, ka0##X.w}, b0w[4] = {kb0##X.x, kb0##X.y, kb0##X.z, kb0##X.w}, a1w[4] = {ka1##X.x, ka1##X.y, ka1##X.z, ka1##X.w}, b1w[4] = {kb1##X.x, kb1##X.y, kb1##X.z, kb1##X.w}; \
            const unsigned v0w[4] = {v0##X.x, v0##X.y, v0##X.z, v0##X.w}, v1w[4] = {v1##X.x, v1##X.y, v1##X.z, v1##X.w}; \
            unsigned* kT32 = (unsigned*)(kT + (BUF) * SCAN_BUF + (8 * p8) * LP + cw); unsigned* vT32 = (unsigned*)(vTl + (BUF) * SCAN_BUF + (8 * p8) * LP + cw); \
            _Pragma("unroll") for (int j = 0; j < 8; ++j) { \
                const float x10 = (j & 1) ? bf_hi(a0w[j >> 1]) : bf_lo(a0w[j >> 1]), x20 = (j & 1) ? bf_hi(b0w[j >> 1]) : bf_lo(b0w[j >> 1]); \
                const float x11 = (j & 1) ? bf_hi(a1w[j >> 1]) : bf_lo(a1w[j >> 1]), x21 = (j & 1) ? bf_hi(b1w[j >> 1]) : bf_lo(b1w[j >> 1]); \
                kT32[j * (LP / 2)] = cvt_pk_bf16(x10 * co0[j] - x20 * si0[j], x11 * co1[j] - x21 * si1[j]); \
                kT32[(64 + j) * (LP / 2)] = cvt_pk_bf16(x10 * si0[j] + x20 * co0[j], x11 * si1[j] + x21 * co1[j]); \
                const float vv0 = (j & 1) ? bf_hi(v0w[j >> 1]) : bf_lo(v0w[j >> 1]), vv1 = (j & 1) ? bf_hi(v1w[j >> 1]) : bf_lo(v1w[j >> 1]); \
                vT32[j * (LP / 2)] = cvt_pk_bf16(vv0 * wdec0, vv1 * wdec1); \
            } } while (0)
#define SCAN_MMA(BUF) do { \
            _Pragma("unroll") for (int kh = 0; kh < 4; kh += 2) { bf16x8 bfr[2], af[2][4]; \
                _Pragma("unroll") for (int u = 0; u < 2; ++u) { const int ks = kh + u; \
                    bfr[u] = *(const bf16x8*)(vTl + (BUF) * SCAN_BUF + (16 * et + fr) * LP + ((32 * ks + 8 * fq) ^ (((2 * et + (fr >> 3)) & 3) << 4))); \
                    _Pragma("unroll") for (int dt = 0; dt < 4; ++dt) af[u][dt] = *(const bf16x8*)(kT + (BUF) * SCAN_BUF + (16 * (dbase + dt) + fr) * LP + ((32 * ks + 8 * fq) ^ (((2 * (dbase + dt) + (fr >> 3)) & 3) << 4))); } \
                __builtin_amdgcn_s_setprio(1); \
                _Pragma("unroll") for (int u = 0; u < 2; ++u) \
                    _Pragma("unroll") for (int dt = 0; dt < 4; ++dt) acc[dt] = __builtin_amdgcn_mfma_f32_16x16x32_bf16(af[u][dt], bfr[u], acc[dt], 0, 0, 0); \
                __builtin_amdgcn_s_setprio(0); \
            } } while (0)
#define SCAN_STORE(st) do { \
            bf16_t* sp = states + ((size_t)((bh * 2 + dir) * 32 + SCAN_NCH(st))) * 16384 + (64 * half + 16 * et + fr) * 128 + 16 * dbase + 4 * fq; \
            _Pragma("unroll") for (int dt = 0; dt < 4; ++dt) { u32x2 w; w.x = cvt_pk_bf16(acc[dt][0], acc[dt][1]); w.y = cvt_pk_bf16(acc[dt][2], acc[dt][3]); *(u32x2*)(sp + 16 * dt) = w; } } while (0)
#define SCAN_BAR() do { asm volatile("s_waitcnt lgkmcnt(0)" ::: "memory"); __builtin_amdgcn_s_barrier(); asm volatile("" ::: "memory"); } while (0)
        SCAN_LOAD(A, SCAN_NCH(0)); SCAN_LOAD(B, SCAN_NCH(1));
        SCAN_WRITE(A, 0);
        SCAN_LOAD(A, SCAN_NCH(2));
        SCAN_BAR();
        for (int step = 0; step < 30; step += 2) {
            SCAN_STORE(step);
#pragma unroll
            for (int dt = 0; dt < 4; ++dt) acc[dt] *= cdec;
            SCAN_WRITE(B, 1); if (step + 3 <= 30) SCAN_LOAD(B, SCAN_NCH(step + 3));
            SCAN_MMA(0);
            SCAN_BAR();
            SCAN_STORE(step + 1);
#pragma unroll
            for (int dt = 0; dt < 4; ++dt) acc[dt] *= cdec;
            SCAN_WRITE(A, 0); if (step + 4 <= 30) SCAN_LOAD(A, SCAN_NCH(step + 4));
            SCAN_MMA(1);
            SCAN_BAR();
        }
        SCAN_STORE(30);
#pragma unroll
        for (int dt = 0; dt < 4; ++dt) acc[dt] *= cdec;
        SCAN_MMA(0);
        SCAN_STORE(31);
#undef SCAN_WRITE
#undef SCAN_MMA
#undef SCAN_STORE
#undef SCAN_BAR
#undef SCAN_NCH
#undef SCAN_LOAD
        __syncthreads();
    }
}

__device__ __forceinline__ void ret_out(const bf16_t* proj, const float* cosT, const float* sinT, const float* decay, const float* gn_g, const float* gn_b,
                        const bf16_t* states, bf16_t* mix, unsigned char* lds, int tid, int bx) {
    bf16_t* Kl = (bf16_t*)lds;
    bf16_t* Vl = Kl + 128 * LP;
    LAS unsigned char* ldsl = (LAS unsigned char*)lds;
    const int wave = __builtin_amdgcn_readfirstlane(tid >> 6);
    float* gnl = (float*)(lds + ST_OFF + 65536);
    for (int i = tid; i < 768; i += 512) { gnl[i] = gn_g[i]; gnl[768 + i] = gn_b[i]; }
    for (int task = bx; task < 1536; task += gridDim.x) {
        int tl = tid; asm volatile("" : "+v"(tl));
        const int lane = tl & 63, fr = lane & 15, fq = lane >> 4, c = tl >> 2, part = tl & 3, cw = c ^ (part << 4);
        const int n = task & 31, bh = task >> 5, b = bh / 6, h = bh % 6;
        const float lgf2 = -__expf(decay[h]) * 1.4426950408889634f, lgb2 = -__expf(decay[6 + h]) * 1.4426950408889634f;
        const int cq = 16 * wave + fr, tq = n * 128 + cq; const size_t rowq = (size_t)(b * SEQ + tq) * LDR;
        __syncthreads();
        {
            const char* spb = (const char*)(states + ((size_t)(bh * 2) * 32 + n) * 16384);
#pragma unroll
            for (int dir = 0; dir < 2; ++dir)
#pragma unroll
                for (int q4 = 0; q4 < 4; ++q4) { const int pc = wave + 8 * q4, e = 4 * pc + (lane >> 4), ch = (lane & 15) ^ (e & 15);
                    __builtin_amdgcn_global_load_lds((const unsigned*)(spb + (size_t)dir * (32 * 16384 * 2) + e * 256 + ch * 16), (LAS unsigned*)(ldsl + ST_OFF + dir * 32768 + pc * 1024), 16, 0, 0); }
        }
        u32x4 qr[4]; float4 qc[2][2], qs[2][2];
        { const bf16_t* qp = proj + rowq + h * 128 + 8 * fq;
#pragma unroll
          for (int ks = 0; ks < 4; ++ks) qr[ks] = *(const u32x4*)(qp + 32 * ks);
#pragma unroll
          for (int k2 = 0; k2 < 2; ++k2) { const float* cp = cosT + tq * 64 + 32 * k2 + 8 * fq; const float* snp = sinT + tq * 64 + 32 * k2 + 8 * fq;
              qc[k2][0] = *(const float4*)cp; qc[k2][1] = *(const float4*)(cp + 4); qs[k2][0] = *(const float4*)snp; qs[k2][1] = *(const float4*)(snp + 4); } }
        {
            const int t = n * 128 + c; const size_t row = (size_t)(b * SEQ + t) * LDR;
            const bf16_t* kp = proj + row + 768 + h * 128 + 16 * part;
            const u32x4 k1a = *(const u32x4*)kp, k1b = *(const u32x4*)(kp + 8), k2a = *(const u32x4*)(kp + 64), k2b = *(const u32x4*)(kp + 72);
            const float* cp = cosT + t * 64 + 16 * part; const float* snp = sinT + t * 64 + 16 * part;
            const int cpv = tl >> 3, p8v = tl & 7, c0v = 2 * cpv;
            const bf16_t* vp = proj + (size_t)(b * SEQ + n * 128 + c0v) * LDR + 1536 + h * 128 + 16 * p8v;
            u32x4 vv[4];
            vv[0] = *(const u32x4*)vp; vv[1] = *(const u32x4*)(vp + 8); vv[2] = *(const u32x4*)(vp + LDR); vv[3] = *(const u32x4*)(vp + LDR + 8);
            float cs[16], sn[16];
#pragma unroll
            for (int q4 = 0; q4 < 4; ++q4) { const float4 cv = *(const float4*)(cp + 4 * q4), sv = *(const float4*)(snp + 4 * q4);
                cs[4 * q4] = cv.x; cs[4 * q4 + 1] = cv.y; cs[4 * q4 + 2] = cv.z; cs[4 * q4 + 3] = cv.w; sn[4 * q4] = sv.x; sn[4 * q4 + 1] = sv.y; sn[4 * q4 + 2] = sv.z; sn[4 * q4 + 3] = sv.w; }
            const unsigned k1w[8] = {k1a.x, k1a.y, k1a.z, k1a.w, k1b.x, k1b.y, k1b.z, k1b.w}, k2w[8] = {k2a.x, k2a.y, k2a.z, k2a.w, k2b.x, k2b.y, k2b.z, k2b.w};
            unsigned r1[8], r2[8];
#pragma unroll
            for (int w2 = 0; w2 < 8; ++w2) {
                const float a1 = bf_lo(k1w[w2]), b1 = bf_hi(k1w[w2]), a2 = bf_lo(k2w[w2]), b2 = bf_hi(k2w[w2]);
                r1[w2] = cvt_pk_bf16(a1 * cs[2 * w2] - a2 * sn[2 * w2], b1 * cs[2 * w2 + 1] - b2 * sn[2 * w2 + 1]);
                r2[w2] = cvt_pk_bf16(a1 * sn[2 * w2] + a2 * cs[2 * w2], b1 * sn[2 * w2 + 1] + b2 * cs[2 * w2 + 1]);
            }
            *(u32x4*)(Kl + c * LP + 16 * part) = (u32x4){r1[0], r1[1], r1[2], r1[3]}; *(u32x4*)(Kl + c * LP + 16 * part + 8) = (u32x4){r1[4], r1[5], r1[6], r1[7]};
            *(u32x4*)(Kl + c * LP + 64 + 16 * part) = (u32x4){r2[0], r2[1], r2[2], r2[3]}; *(u32x4*)(Kl + c * LP + 64 + 16 * part + 8) = (u32x4){r2[4], r2[5], r2[6], r2[7]};
            { const unsigned t0w[8] = {vv[0].x, vv[0].y, vv[0].z, vv[0].w, vv[1].x, vv[1].y, vv[1].z, vv[1].w}, t1w[8] = {vv[2].x, vv[2].y, vv[2].z, vv[2].w, vv[3].x, vv[3].y, vv[3].z, vv[3].w};
              unsigned* V32 = (unsigned*)(Vl + (16 * p8v) * LP + (c0v ^ ((p8v & 3) << 4)));
#pragma unroll
              for (int j = 0; j < 16; ++j) { const unsigned x0 = (j & 1) ? (t0w[j >> 1] >> 16) : (t0w[j >> 1] & 0xffffu), x1 = (j & 1) ? (t1w[j >> 1] & 0xffff0000u) : (t1w[j >> 1] << 16);
                  V32[j * (LP / 2)] = x0 | x1; } }
        }
        asm volatile("s_waitcnt vmcnt(0)" ::: "memory");
        __syncthreads();
        u32x2 gwv[8];
        { const bf16_t* gp0 = proj + rowq + 2304 + h * 128 + 4 * fq;
#pragma unroll
          for (int e8 = 0; e8 < 8; ++e8) gwv[e8] = *(const u32x2*)(gp0 + 16 * e8); }
        bf16x8 qf[4];
#pragma unroll
        for (int k2 = 0; k2 < 2; ++k2) {
            const float cs[8] = {qc[k2][0].x, qc[k2][0].y, qc[k2][0].z, qc[k2][0].w, qc[k2][1].x, qc[k2][1].y, qc[k2][1].z, qc[k2][1].w};
            const float sn[8] = {qs[k2][0].x, qs[k2][0].y, qs[k2][0].z, qs[k2][0].w, qs[k2][1].x, qs[k2][1].y, qs[k2][1].z, qs[k2][1].w};
            const unsigned x1w[4] = {qr[k2].x, qr[k2].y, qr[k2].z, qr[k2].w}, x2w[4] = {qr[k2 + 2].x, qr[k2 + 2].y, qr[k2 + 2].z, qr[k2 + 2].w};
            unsigned o1[4], o2[4];
#pragma unroll
            for (int w2 = 0; w2 < 4; ++w2) { const float a1 = bf_lo(x1w[w2]), b1 = bf_hi(x1w[w2]), a2 = bf_lo(x2w[w2]), b2 = bf_hi(x2w[w2]);
                o1[w2] = cvt_pk_bf16(a1 * cs[2 * w2] - a2 * sn[2 * w2], b1 * cs[2 * w2 + 1] - b2 * sn[2 * w2 + 1]);
                o2[w2] = cvt_pk_bf16(a1 * sn[2 * w2] + a2 * cs[2 * w2], b1 * sn[2 * w2 + 1] + b2 * cs[2 * w2 + 1]); }
            const u32x4 p1 = (u32x4){o1[0], o1[1], o1[2], o1[3]}, p2 = (u32x4){o2[0], o2[1], o2[2], o2[3]};
            __builtin_memcpy(&qf[k2], &p1, 16); __builtin_memcpy(&qf[k2 + 2], &p2, 16);
        }
        bf16x8 pf[4];
#pragma unroll
        for (int s = 0; s < 4; ++s) {
            f32x4 st2[2];
#pragma unroll
            for (int pp = 0; pp < 2; ++pp) {
                const bf16_t* kr = Kl + (32 * s + 8 * (fr >> 2) + 4 * pp + (fr & 3)) * LP + 8 * fq;
                f32x4 a = (f32x4){0.f, 0.f, 0.f, 0.f};
#pragma unroll
                for (int ks = 0; ks < 4; ++ks) a = __builtin_amdgcn_mfma_f32_16x16x32_bf16(*(const bf16x8*)(kr + 32 * ks), qf[ks], a, 0, 0, 0);
#pragma unroll
                for (int r = 0; r < 4; ++r) { const int sk = 32 * s + 8 * fq + 4 * pp + r, diff = cq - sk;
                    const float df = (float)diff;
                    const float dd = __builtin_amdgcn_exp2f(fminf(lgf2 * df, -lgb2 * df)) + fmaxf(1.0f - fabsf(df), 0.0f);
                    a[r] *= dd * 0.08838834764831845f; }
                st2[pp] = a;
            }
            const u32x4 pw = (u32x4){cvt_pk_bf16(st2[0][0], st2[0][1]), cvt_pk_bf16(st2[0][2], st2[0][3]), cvt_pk_bf16(st2[1][0], st2[1][1]), cvt_pk_bf16(st2[1][2], st2[1][3])};
            __builtin_memcpy(&pf[s], &pw, 16);
        }
        f32x4 acc[8];
#pragma unroll
        for (int e8 = 0; e8 < 8; ++e8) acc[e8] = (f32x4){0.f, 0.f, 0.f, 0.f};
#pragma unroll
        for (int s = 0; s < 4; ++s)
#pragma unroll
            for (int e8 = 0; e8 < 8; ++e8) acc[e8] = __builtin_amdgcn_mfma_f32_16x16x32_bf16(*(const bf16x8*)(Vl + (16 * e8 + fr) * LP + ((32 * s + 8 * fq) ^ ((e8 & 3) << 4))), pf[s], acc[e8], 0, 0, 0);
#pragma unroll
        for (int dir = 0; dir < 2; ++dir) {
            const unsigned char* sl = lds + ST_OFF + dir * 32768 + fr * 256;
            const float sc = dir == 0 ? __builtin_amdgcn_exp2f(lgf2 * (float)(cq + 1)) : __builtin_amdgcn_exp2f(lgb2 * (float)(128 - cq));
#pragma unroll
            for (int e8 = 0; e8 < 8; ++e8) {
                f32x4 a2 = (f32x4){0.f, 0.f, 0.f, 0.f};
#pragma unroll
                for (int ks = 0; ks < 4; ++ks) a2 = __builtin_amdgcn_mfma_f32_16x16x32_bf16(*(const bf16x8*)(sl + e8 * 4096 + (((4 * ks + fq) ^ fr) << 4)), qf[ks], a2, 0, 0, 0);
                acc[e8] += a2 * sc;
            }
        }
        float sm = 0.f;
#pragma unroll
        for (int e8 = 0; e8 < 8; ++e8) sm += (acc[e8][0] + acc[e8][1]) + (acc[e8][2] + acc[e8][3]);
        sm += __shfl_xor(sm, 16); sm += __shfl_xor(sm, 32);
        const float mu = sm * (1.0f / 128.0f);
        float vs = 0.f;
#pragma unroll
        for (int e8 = 0; e8 < 8; ++e8)
#pragma unroll
            for (int r = 0; r < 4; ++r) { const float dlt = acc[e8][r] - mu; vs += dlt * dlt; }
        vs += __shfl_xor(vs, 16); vs += __shfl_xor(vs, 32);
        const float rstd = 1.0f / sqrtf(vs * (1.0f / 128.0f) + 1e-5f);
        bf16_t* op = mix + (size_t)(b * SEQ + tq) * 1024 + h * 128 + 4 * fq;
#pragma unroll
        for (int e8 = 0; e8 < 8; ++e8) {
            const u32x2 gw = gwv[e8];
            const float4 gg = *(const float4*)(gnl + h * 128 + 16 * e8 + 4 * fq), gb = *(const float4*)(gnl + 768 + h * 128 + 16 * e8 + 4 * fq);
            const float y0 = ((acc[e8][0] - mu) * rstd * gg.x + gb.x) * silu_f(bf_lo(gw.x));
            const float y1 = ((acc[e8][1] - mu) * rstd * gg.y + gb.y) * silu_f(bf_hi(gw.x));
            const float y2 = ((acc[e8][2] - mu) * rstd * gg.z + gb.z) * silu_f(bf_lo(gw.y));
            const float y3 = ((acc[e8][3] - mu) * rstd * gg.w + gb.w) * silu_f(bf_hi(gw.y));
            u32x2 w; w.x = cvt_pk_bf16(y0, y1); w.y = cvt_pk_bf16(y2, y3);
            *(u32x2*)(op + 16 * e8) = w;
        }
    }
    __syncthreads();
}

#define XB_TMO      128
#define XB_XCNT(j)  (256  + 64 * (j))
#define XB_XSUB(j)  (1280 + 64 * (j))
#define XB_XGEN(j)  (2304 + 64 * (j))
#define XB_TOP      3328
#define XB_TOPGEN   3392
#define XCD_BAR_WORDS 3456
#define XB_SPIN_CAP (1u << 18)
__device__ __forceinline__ unsigned xb_ld(unsigned* p)              { return __hip_atomic_load(p, __ATOMIC_RELAXED, __HIP_MEMORY_SCOPE_AGENT); }
__device__ __forceinline__ unsigned xb_add(unsigned* p, unsigned v) { return __hip_atomic_fetch_add(p, v, __ATOMIC_RELAXED, __HIP_MEMORY_SCOPE_AGENT); }
__device__ __forceinline__ unsigned xb_xcc_id() { return (unsigned)__builtin_amdgcn_s_getreg((3 << 11) | 20) & 0xFu; }
#define XB_SPIN(cond, bar) do { unsigned _sp = 0; while (cond) { __builtin_amdgcn_s_sleep(1); \
    if ((++_sp & 255u) == 0u) { if (xb_ld(&(bar)[XB_TMO])) break; if (_sp > XB_SPIN_CAP) { atomicAdd(&(bar)[XB_TMO], 1u); break; } } } } while (0)
struct XcdBarrier { unsigned* bar; unsigned x; volatile LAS unsigned* st; };
__device__ __forceinline__ XcdBarrier xcd_barrier_post(unsigned* bar, volatile LAS unsigned* st) {
    XcdBarrier b; b.bar = bar; b.x = xb_xcc_id(); b.st = st;
    if (threadIdx.x == 0) (void)xb_add(&bar[XB_XCNT(b.x)], 1u);
    return b;
}
__device__ __forceinline__ void xcd_barrier_complete(unsigned* bar, unsigned x, unsigned& nloc, unsigned& nx) {
    const unsigned G = gridDim.x * gridDim.y * gridDim.z;
    unsigned sum, cnt, mine, sp = 0u;
    for (;;) {
        sum = 0u; cnt = 0u; mine = 0u;
#pragma unroll
        for (unsigned j = 0; j < 16; ++j) { const unsigned c = xb_ld(&bar[XB_XCNT(j)]); sum += c; cnt += (c > 0u) ? 1u : 0u; mine = (j == x) ? c : mine; }
        if (sum == G) break;
        __builtin_amdgcn_s_sleep(1);
        if ((++sp & 255u) == 0u) { if (xb_ld(&bar[XB_TMO])) break; if (sp > XB_SPIN_CAP) { atomicAdd(&bar[XB_TMO], 1u); break; } }
    }
    nloc = mine > 0u ? mine : 1u; nx = cnt > 0u ? cnt : 1u;
}
__device__ __forceinline__ void xcd_barrier(const XcdBarrier& b, bool leader) {
    asm volatile("s_waitcnt vmcnt(0)" ::: "memory");
    __syncthreads();
    if (leader) {
        unsigned* bar = b.bar;
        __builtin_amdgcn_s_waitcnt(0);
        unsigned nloc = b.st[0], nx = b.st[1];
        if (nloc == 0u) { xcd_barrier_complete(bar, b.x, nloc, nx); b.st[0] = nloc; b.st[1] = nx; }
        const unsigned old = xb_add(&bar[XB_XSUB(b.x)], 1u);
        const unsigned gen = old / nloc;
        if (old + 1u == (gen + 1u) * nloc) {
            __builtin_amdgcn_fence(__ATOMIC_RELEASE, "agent");
            asm volatile("s_waitcnt vmcnt(0)" ::: "memory");
            const unsigned og = xb_add(&bar[XB_TOP], 1u);
            const unsigned tg = og / nx;
            if (og + 1u == (tg + 1u) * nx) xb_add(&bar[XB_TOPGEN], 1u);
            else XB_SPIN(xb_ld(&bar[XB_TOPGEN]) == tg, bar);
            __builtin_amdgcn_fence(__ATOMIC_ACQUIRE, "agent");
            xb_add(&bar[XB_XGEN(b.x)], 1u);
            asm volatile("s_waitcnt vmcnt(0)" ::: "memory");
        } else {
            XB_SPIN(xb_ld(&bar[XB_XGEN(b.x)]) == gen, bar);
            __builtin_amdgcn_fence(__ATOMIC_ACQUIRE, "agent");
            asm volatile("s_waitcnt vmcnt(0)" ::: "memory");
        }
    }
    __syncthreads();
}

constexpr int N_PH = 33;
__host__ __device__ inline bool phase_exists(int ph) { if (ph == 0) return true; const int i = (ph - 1) >> 3, s = (ph - 1) & 7; return !((i & 1) && s == 1); }

__device__ __forceinline__ int fresh_tid(int wave_s) { int t = wave_s * 64 + (int)__builtin_amdgcn_mbcnt_hi(~0u, __builtin_amdgcn_mbcnt_lo(~0u, 0u)); asm volatile("" : "+v"(t)); return t; }
__global__ void __launch_bounds__(512, 2) mega(Params p) {
    extern __shared__ __attribute__((aligned(16))) unsigned char lds[];
    LAS unsigned char* ldsl = (LAS unsigned char*)lds;
    const int G = gridDim.x;
    volatile LAS unsigned* xst = (volatile LAS unsigned*)(ldsl + LDS_BYTES - 16);
    if (threadIdx.x < 4) xst[threadIdx.x] = 0u;
    __syncthreads();
    const XcdBarrier xbar = xcd_barrier_post((unsigned*)(p.ws + WS_BAR), xst);
#define abuf ((bf16_t*)(wsp + WS_ABUF))
#define r1 ((bf16_t*)(wsp + WS_R1))
#define mix ((bf16_t*)(wsp + WS_MIX))
#define Wb ((bf16_t*)(wsp + WS_W))
#define states ((bf16_t*)(wsp + WS_ST))
#define memw ((bf16_t*)(wsp + WS_MEMW))
#define memn ((bf16_t*)(wsp + WS_MEMN))
#define mkv ((bf16_t*)(wsp + WS_MKV))
#define mvt ((bf16_t*)(wsp + WS_MVT))
#define cosT ((float*)(wsp + WS_COS))
#define sinT ((float*)(wsp + WS_SIN))
#define vT (r1 + (size_t)MTOK * LDN)
    const int ph_lo = p.ph_lo, ph_hi = p.ph_hi;
    const int wave_s = __builtin_amdgcn_readfirstlane((int)(threadIdx.x >> 6));
#define tid fresh_tid(wave_s)
#define PHASE_IDS() int bx = blockIdx.x; asm volatile("" : "+s"(bx)); \
        kargp_t ka = (kargp_t)__builtin_amdgcn_kernarg_segment_ptr(); asm volatile("" : "+s"(ka)); unsigned char* const wsp = KARG(unsigned char*, ws)
    if (ph_lo == 0) {
        PHASE_IDS();
            wconv(KARG(const float*, mem_w_kv), 1024, 512, memw, 0, lds, tid, bx);
            rownorm_first(KARG(const float*, x), KARG(const float*, norm_g), abuf, MTOK, tid, bx);
            rownorm_first(KARG(const float*, mem), KARG(const float*, mem_norm_g), memn, 2048, tid, bx);
            rope_table(cosT, sinT, tid, bx);
        conv_layer_weights(ka, 0, lds, tid, bx);
        if (ph_hi > 4096) cg::this_grid().sync();
        else if (ph_hi > 1) xcd_barrier(xbar, tid == 0);
    }
    for (int ph = ph_lo > 1 ? ph_lo : 1; ph < ph_hi; ++ph) {
        if (!phase_exists(ph)) continue;
        PHASE_IDS();
        {
            const int i = (ph - 1) >> 3, s = (ph - 1) & 7, j = i >> 1; const bool ret = !(i & 1);
            const float* ng = KARG(const float*, norm_g) + (size_t)i * 4 * 1024;
            const int ng_gemm = (s == 0) ? (ret ? (i == 0 ? 3 : 1) : 2) : ((s == 3 || s == 6) ? 1 : 0);
            for (int gi = 0; gi < ng_gemm; ++gi) {
                pg8::Gemm g; bf16_t* o; int ld;
                if (s == 0) {
                    if (gi == 0)      { g = pg8::Gemm{abuf, Wb + W_IN_OFF, MTOK, ret ? LDR : LDN, 1024}; o = r1; ld = ret ? LDR : LDN; }
                    else if (!ret)    { g = pg8::Gemm{Wb + W_IN_OFF + (size_t)LDN * 1024, abuf, 768, MTOK, 1024}; o = vT; ld = MTOK; }
                    else if (gi == 1) { g = pg8::Gemm{memn, memw, 2048, 256, 1024}; o = mkv; ld = 256; }
                    else              { g = pg8::Gemm{memw + (size_t)256 * 1024, memn, 256, 2048, 1024}; o = mvt; ld = 2048; }
                } else if (s == 3)    { g = pg8::Gemm{mix, Wb + W_OUT_OFF, MTOK, 1024, 1024}; o = abuf; ld = 1024; }
                else                  { g = pg8::Gemm{r1, Wb + W_F2_OFF, MTOK, 1024, FF}; o = abuf; ld = 1024; }
                const int off = gi == 0 ? 0 : (gi == 1 ? G / 2 : G / 2 + 8);
                pg8::StaticOrder S; S.init(g.M, g.N, G, (bx + G - off) % G);
                pg8::EpiBf16 E{o, ld};
                pg8::gemm_phase<pg8::EpiBf16, pg8::StaticOrder>(ldsl, g, S, E, tid);
            }
            if (s == 5) { pg8::Gemm g{abuf, Wb + W_F1_OFF, MTOK, 2 * FF, 1024}; pg8::StaticOrder S; S.init(g.M, g.N, G, bx);
                pg8::EpiSwiglu E{r1, FF}; pg8::gemm_phase<pg8::EpiSwiglu, pg8::StaticOrder>(ldsl, g, S, E, tid); }
            if (s == 1) ret_scan(r1, cosT, sinT, KARG(const float*, ret_decay) + j * 12, states, lds, tid, bx);
            if (s == 2) {
                if (ret) ret_out(r1, cosT, sinT, KARG(const float*, ret_decay) + j * 12, KARG(const float*, ret_gn_g) + j * 768, KARG(const float*, ret_gn_b) + j * 768, states, mix, lds, tid, bx);
                else     na_phase(r1, vT, KARG(const float*, na_rpb) + (size_t)j * 12 * 465, mix, lds, tid, bx);
            }
            if ((ret && s == 1) || (!ret && s == 2)) memattn_phase(r1, ret ? LDR : LDN, ret ? 3072 : 1536, mkv, mvt, mix, (unsigned*)(wsp + WS_BAR) + 3584 + 64 * i, lds, tid, bx);
            if (s == 4 || s == 7) rowpass(abuf, (i == 0 && s == 4) ? KARG(const float*, x) : KARG(float*, out), KARG(float*, out), ng + (s == 4 ? 1024 : 3072), s == 4 ? ng + 2048 : (i < 3 ? ng + 4096 : nullptr), abuf, tid, bx);

        }
        if (ph >= 8 && ph < 32 && ((ph - 1) & 7) == 7) conv_layer_weights(ka, ((ph - 1) >> 3) + 1, lds, tid, bx);
        if (ph + 1 < ph_hi) xcd_barrier(xbar, tid == 0);
    }
}

#undef PHASE_IDS
#undef tid
#undef abuf
#undef r1
#undef mix
#undef Wb
#undef states
#undef memw
#undef memn
#undef mkv
#undef mvt
#undef cosT
#undef sinT
#undef vT
extern "C" void kernel_launch(void* const* d_in, const int* in_sizes, int n_in, void* d_out, int out_size, void* d_ws, size_t ws_size, hipStream_t stream) {
    static int grid = 0;
    if (grid == 0) {
        if (n_in != 15 || out_size != MTOK * DM || ws_size < WS_END) { fprintf(stderr, "kernel_launch: unexpected shapes (n_in %d out %d ws %zu need %zu)\n", n_in, out_size, ws_size, (size_t)WS_END); grid = -1; return; }
        int dev = 0, cus = 0, per_cu = 0;
        hipGetDevice(&dev); hipDeviceGetAttribute(&cus, hipDeviceAttributeMultiprocessorCount, dev);
        hipFuncSetAttribute((const void*)mega, hipFuncAttributeMaxDynamicSharedMemorySize, LDS_BYTES);
        hipOccupancyMaxActiveBlocksPerMultiprocessor(&per_cu, (const void*)mega, 512, LDS_BYTES);
        if (per_cu < 1) per_cu = 1;
        if (per_cu > 1) per_cu = 1;
        (void)hipGetLastError();
        grid = cus * per_cu;
    }
    if (grid < 0) return;
    if (hipMemsetAsync((char*)d_ws + WS_BAR, 0, 16384, stream) != hipSuccess) fprintf(stderr, "kernel_launch: memset of barrier words failed\n");
    Params p{};
    p.x = (const float*)d_in[0]; p.mem = (const float*)d_in[1]; p.norm_g = (const float*)d_in[2]; p.mem_norm_g = (const float*)d_in[3]; p.mem_w_kv = (const float*)d_in[4];
    p.ret_w_in = (const float*)d_in[5]; p.ret_w_out = (const float*)d_in[6]; p.ret_gn_g = (const float*)d_in[7]; p.ret_gn_b = (const float*)d_in[8]; p.ret_decay = (const float*)d_in[9];
    p.na_w_in = (const float*)d_in[10]; p.na_w_out = (const float*)d_in[11]; p.na_rpb = (const float*)d_in[12]; p.ffn_w_in = (const float*)d_in[13]; p.ffn_w_out = (const float*)d_in[14];
    p.out = (float*)d_out; p.ws = (unsigned char*)d_ws;
#if ONE_LAUNCH
    p.ph_lo = 0; p.ph_hi = N_PH;
    void* args[] = {&p};
    hipError_t e = hipLaunchCooperativeKernel((const void*)mega, dim3(grid), dim3(512), args, LDS_BYTES, stream);
    if (e != hipSuccess) fprintf(stderr, "cooperative launch failed: %s (grid %d)\n", hipGetErrorString(e), grid);
#else
    for (int ph = 0; ph < N_PH; ++ph) { if (!phase_exists(ph)) continue; p.ph_lo = ph; p.ph_hi = ph + 1;
        hipLaunchKernelGGL(mega, dim3(grid), dim3(512), LDS_BYTES, stream, p); }
#endif
}
```
